# Optimizing an MI355X kernel written in HIP

```python
import math
import jax, jax.numpy as jnp
from jax import lax
import numpy as np

D_MODEL = 2048
BATCH = 16
SEQ = 2048
DEPTH = 4
DEC_BATCH = 8
DEC_SEQ = 2048
PAST_LEN = 128

HEAD_DIM = 128
ATT_WIDTH = 3 * D_MODEL // 4
POOL_WIDTH = D_MODEL - ATT_WIDTH
N_HEADS = ATT_WIDTH // HEAD_DIM
DILATED_GROUPS = ((128, 1), (512, 4), (2048, 16))
N_GROUPS = len(DILATED_GROUPS)
QKV_WIDTH = N_GROUPS * 3 * ATT_WIDTH
IN_WIDTH = QKV_WIDTH + POOL_WIDTH
POOL_WINDOWS = (2, 4, 8, 16)
POOL_GROUP = POOL_WIDTH // len(POOL_WINDOWS)
D_FF = 5632
N_BUCKETS = 32
MAX_DISTANCE = 1024
EPS = 1e-6
NEG_INF = -1e30

kernel_name = "hybrid_dilated_attn_pool_macaron_encoder"


def rmsnorm(x, g):
    xf = x.astype(jnp.float32)
    y = xf * lax.rsqrt(jnp.mean(xf * xf, axis=-1, keepdims=True) + EPS)
    return (y * g.astype(jnp.float32)).astype(x.dtype)


def swiglu(x, wg, wu, wd):
    return (jax.nn.silu(x @ wg) * (x @ wu)) @ wd


def t5_bucket(rel):
    half = N_BUCKETS // 2
    max_exact = half // 2
    ret = jnp.where(rel > 0, half, 0)
    n = jnp.abs(rel)
    nf = jnp.maximum(n, 1).astype(jnp.float32)
    large = max_exact + (jnp.log(nf / max_exact) / math.log(MAX_DISTANCE / max_exact)
                         * (half - max_exact)).astype(jnp.int32)
    large = jnp.minimum(large, half - 1)
    return ret + jnp.where(n < max_exact, n, large)


def dilated_group_attention(q, k, v, bias_table, dilation, side):
    B, S, H, hd = q.shape
    L = S // dilation
    nblk = -(-L // side)
    Lp = nblk * side

    def to_classes(t):
        t = t.reshape(B, L, dilation, H, hd).transpose(0, 2, 1, 3, 4)
        return jnp.pad(t, ((0, 0), (0, 0), (0, Lp - L), (0, 0), (0, 0)))

    qc, kc, vc = to_classes(q), to_classes(k), to_classes(v)
    qb = qc.reshape(B, dilation, nblk, side, H, hd)

    def windows(t):
        tp = jnp.pad(t, ((0, 0), (0, 0), (side, side), (0, 0), (0, 0)))
        tb = tp.reshape(B, dilation, nblk + 2, side, H, hd)
        return jnp.concatenate([tb[:, :, :-2], tb[:, :, 1:-1], tb[:, :, 2:]], axis=3)

    kw, vw = windows(kc), windows(vc)

    qi = jnp.arange(side)[:, None]
    kj = jnp.arange(3 * side)[None, :]
    delta = kj - side - qi
    kpos = jnp.arange(nblk)[:, None] * side + jnp.arange(3 * side)[None, :] - side
    valid = (kpos >= 0) & (kpos < L)
    mask = valid[:, None, :] & (jnp.abs(delta) <= side)[None]
    bias = bias_table.astype(jnp.float32)[t5_bucket(delta * dilation)].transpose(2, 0, 1)

    s = jnp.einsum('bcnqhd,bcnkhd->bcnhqk', qb, kw,
                   preferred_element_type=jnp.float32) * (HEAD_DIM ** -0.5)
    s = s + bias[None, None, None]
    s = jnp.where(mask[None, None, :, None], s, NEG_INF)
    m = jnp.max(s, axis=-1, keepdims=True)
    p = jnp.exp(s - m)
    l = jnp.sum(p, axis=-1, keepdims=True)
    o = jnp.einsum('bcnhqk,bcnkhd->bcnqhd', p / l, vw.astype(jnp.float32))
    lse = (m + jnp.log(l))[..., 0]

    o = o.reshape(B, dilation, Lp, H, hd)[:, :, :L].transpose(0, 2, 1, 3, 4).reshape(B, S, H, hd)
    lse = lse.transpose(0, 1, 2, 4, 3).reshape(B, dilation, Lp, H)[:, :, :L]
    lse = lse.transpose(0, 2, 1, 3).reshape(B, S, H)
    return o, lse


def multiscale_pool(u, w_pool, pool_scale):
    B, S, _ = u.shape
    uf = u.astype(jnp.float32)
    cs = jnp.pad(jnp.cumsum(uf, axis=1), ((0, 0), (1, 0), (0, 0)))
    pos = jnp.arange(S)
    diffs = []
    for g, w in enumerate(POOL_WINDOWS):
        h = w // 2
        lo = jnp.maximum(pos - h, 0)
        hi = jnp.minimum(pos + h + 1, S)
        seg = cs[:, :, g * POOL_GROUP:(g + 1) * POOL_GROUP]
        mean = (seg[:, hi] - seg[:, lo]) / (hi - lo).astype(jnp.float32)[None, :, None]
        diffs.append(mean - uf[..., g * POOL_GROUP:(g + 1) * POOL_GROUP])
    d = jnp.stack(diffs, axis=2).astype(u.dtype)
    y = jnp.einsum('bsgc,gce->bsge', d, w_pool).reshape(B, S, POOL_WIDTH)
    return y * pool_scale


def token_mixer(h, w_in, w_pool, pool_scale, w_out, rel_bias):
    B, S, _ = h.shape
    z = h @ w_in
    qkv = z[..., :QKV_WIDTH].reshape(B, S, N_GROUPS, 3, N_HEADS, HEAD_DIM)
    u = z[..., QKV_WIDTH:]
    outs, lses = [], []
    for g, (window, dil) in enumerate(DILATED_GROUPS):
        side = window // (2 * dil)
        o, lse = dilated_group_attention(qkv[:, :, g, 0], qkv[:, :, g, 1], qkv[:, :, g, 2],
                                         rel_bias[:, g * N_HEADS:(g + 1) * N_HEADS], dil, side)
        outs.append(o)
        lses.append(lse)
    wts = jax.nn.softmax(jnp.stack(lses), axis=0)
    att = jnp.einsum('gbsh,gbshd->bshd', wts, jnp.stack(outs)).reshape(B, S, ATT_WIDTH).astype(h.dtype)
    pool = multiscale_pool(u, w_pool, pool_scale).astype(h.dtype)
    return jnp.concatenate([att, pool], axis=-1) @ w_out


def trunk(x, norm_g, ffn_gate, ffn_up, ffn_down, w_in, w_pool, pool_scale, w_out, rel_bias, final_g):
    for l in range(DEPTH):
        x = x + 0.5 * swiglu(rmsnorm(x, norm_g[l, 0]), ffn_gate[l, 0], ffn_up[l, 0], ffn_down[l, 0])
        x = x + token_mixer(rmsnorm(x, norm_g[l, 1]), w_in[l], w_pool[l], pool_scale[l], w_out[l], rel_bias)
        x = x + 0.5 * swiglu(rmsnorm(x, norm_g[l, 2]), ffn_gate[l, 1], ffn_up[l, 1], ffn_down[l, 1])
    return rmsnorm(x, final_g)


def setup_inputs(seed: int = 0) -> dict:
    key = jax.random.key(seed)
    ks = jax.random.split(key, 12)
    f32 = jnp.float32
    x_prompt = jax.random.normal(ks[0], (BATCH, SEQ, D_MODEL), f32)
    x_sample = jax.random.normal(ks[1], (DEC_BATCH, DEC_SEQ, D_MODEL), f32)
    norm_g = 1.0 + 0.02 * jax.random.normal(ks[2], (DEPTH, 3, D_MODEL), f32)
    ffn_gate = jax.random.normal(ks[3], (DEPTH, 2, D_MODEL, D_FF), f32) * D_MODEL ** -0.5
    ffn_up = jax.random.normal(ks[4], (DEPTH, 2, D_MODEL, D_FF), f32) * D_MODEL ** -0.5
    ffn_down = jax.random.normal(ks[5], (DEPTH, 2, D_FF, D_MODEL), f32) * D_FF ** -0.5
    w_in = jax.random.normal(ks[6], (DEPTH, D_MODEL, IN_WIDTH), f32) * D_MODEL ** -0.5
    w_pool = jax.random.normal(ks[7], (DEPTH, len(POOL_WINDOWS), POOL_GROUP, POOL_GROUP), f32) * POOL_GROUP ** -0.5
    pool_scale = 1.0 + 0.02 * jax.random.normal(ks[8], (DEPTH, POOL_WIDTH), f32)
    w_out = jax.random.normal(ks[9], (DEPTH, D_MODEL, D_MODEL), f32) * D_MODEL ** -0.5
    rel_bias = 0.3 * jax.random.normal(ks[10], (N_BUCKETS, N_GROUPS * N_HEADS), f32)
    final_g = 1.0 + 0.02 * jax.random.normal(ks[11], (D_MODEL,), f32)
    return {"x_prompt": x_prompt, "x_sample": x_sample, "norm_g": norm_g, "ffn_gate": ffn_gate,
            "ffn_up": ffn_up, "ffn_down": ffn_down, "w_in": w_in, "w_pool": w_pool,
            "pool_scale": pool_scale, "w_out": w_out, "rel_bias": rel_bias, "final_g": final_g}


def reference(x_prompt, x_sample, norm_g, ffn_gate, ffn_up, ffn_down, w_in, w_pool, pool_scale,
              w_out, rel_bias, final_g):
    y_prompt = trunk(x_prompt, norm_g, ffn_gate, ffn_up, ffn_down, w_in, w_pool, pool_scale,
                     w_out, rel_bias, final_g)
    y_sample = trunk(x_sample, norm_g, ffn_gate, ffn_up, ffn_down, w_in, w_pool, pool_scale,
                     w_out, rel_bias, final_g)
    return (y_prompt, y_sample)
```

```cpp
#include <hip/hip_runtime.h>
#include <cstdio>
#include <cstdint>
namespace pg8 {
#define PG8_LAS __attribute__((address_space(3)))
typedef unsigned short bf16_t;
typedef short bf16x8 __attribute__((ext_vector_type(8)));
typedef float f32x4 __attribute__((ext_vector_type(4)));
typedef unsigned u32x4 __attribute__((ext_vector_type(4)));
typedef int i32x8 __attribute__((ext_vector_type(8)));
typedef int i32x4_ __attribute__((ext_vector_type(4)));
constexpr int BM = 256, BK = 64, HALF = 128, HTB = HALF * BK * 2  , STAGE_BYTES = 8 * HTB, NXCD = 8;

__host__ __device__ __forceinline__ int lds_byte(int r, int c) { const int st = (r >> 4) * 2 + (c >> 5), rr = r & 15, cc = c & 31, ob = rr * 64 + cc * 2; return st * 1024 + (ob ^ (((ob >> 9) & 1) << 5)); }
__host__ __device__ __forceinline__ void stage_rc(int b, int& R, int& C) { const int st = b / 1024, sb = b % 1024, swz = sb ^ (((sb >> 9) & 1) << 5); R = (st >> 1) * 16 + swz / 64; C = (st & 1) * 32 + (swz % 64) / 2; }
__host__ __device__ __forceinline__ int perm32(int rho) { const int n = rho >> 4, i = rho & 15; return 8 * (i >> 2) + 4 * n + (i & 3); }

#ifndef PG8_B_BLOCKED
#define PG8_B_BLOCKED 1
#endif
__host__ __device__ __forceinline__ int inv_perm32(int w) { return 16 * ((w >> 2) & 1) + (((w >> 3) << 2) | (w & 3)); }
__host__ __device__ __forceinline__ size_t bblk_off(int n, int kbyte, int Kb) {
    const int slot = (n & ~31) + inv_perm32(n & 31), ob = (slot & 15) * 64 + (kbyte & 63);
    return ((size_t)(slot >> 4) * (size_t)(Kb >> 6) + (size_t)(kbyte >> 6)) * 1024 + (size_t)(ob ^ (((ob >> 9) & 1) << 5)); }
__device__ __forceinline__ int lane_id_fresh() { int l_; asm volatile("v_mbcnt_lo_u32_b32 %0, -1, 0\n\tv_mbcnt_hi_u32_b32 %0, -1, %0" : "=v"(l_)); return l_; }
struct Unit { int pm, pn; };
struct Gemm { const bf16_t* A; const bf16_t* Bt; int M, N, K; };

struct StaticOrder {
    int nM, nN, nwg, G, c, WGM, rot, pmx;
    __host__ __device__ void init(int M, int N, int G_, int c_, int wgm = 4, int rot_ = 1, int pmx_ = 0) { nM = M / BM; nN = N / BM; nwg = nM * nN; G = G_; c = c_; WGM = wgm; rot = rot_; pmx = pmx_; }
    __host__ __device__ bool next(int i, Unit& u) const {
        const long L = (long)i * G + c; if (L >= nwg) return false;
        int wgid = (int)L; { const int q = nwg / NXCD, r = nwg % NXCD, xcd = wgid % NXCD, off = wgid / NXCD; wgid = (xcd < r ? xcd * (q + 1) : r * (q + 1) + (xcd - r) * q) + off; }
        const int nig = WGM * nN, gid = wgid / nig, fm = gid * WGM, gsz = (nM - fm) < WGM ? (nM - fm) : WGM;
        u.pm = fm + ((wgid % nig) % gsz); u.pn = (wgid % nig) / gsz;
        if (rot) u.pn = (u.pn + (u.pm >> 3) * (nN / NXCD)) % nN;
        u.pm ^= pmx; return true;
    }
    __device__ __forceinline__ void a_ready(const Unit&) const {}
    __device__ __forceinline__ void done(const Unit&) const {}
};
__device__ __forceinline__ unsigned cvt_pk_bf16(float lo, float hi) { unsigned r; asm volatile("v_cvt_pk_bf16_f32 %0, %1, %2" : "=v"(r) : "v"(lo), "v"(hi)); return r; }
typedef float f32x2 __attribute__((ext_vector_type(2)));
typedef unsigned u32x2_ __attribute__((ext_vector_type(2)));
constexpr float RMS_EPS = 1e-6f;
constexpr float INV_D = 1.0f / 2048.0f;
__device__ __forceinline__ float row_rstd(const float* ssp, int row, int fq) {
    const f32x4 a = *(const f32x4*)(ssp + (size_t)row * 32 + 8 * fq), b = *(const f32x4*)(ssp + (size_t)row * 32 + 8 * fq + 4);
    float s = ((a[0] + a[1]) + (a[2] + a[3])) + ((b[0] + b[1]) + (b[2] + b[3]));
    s += __shfl_xor(s, 16); s += __shfl_xor(s, 32);
    return __builtin_amdgcn_rsqf(s * INV_D + RMS_EPS);
}
__device__ __forceinline__ float row_msq(const float* ssp, int row, int fq) {
    const f32x4 a = *(const f32x4*)(ssp + (size_t)row * 32 + 8 * fq), b = *(const f32x4*)(ssp + (size_t)row * 32 + 8 * fq + 4);
    float s = ((a[0] + a[1]) + (a[2] + a[3])) + ((b[0] + b[1]) + (b[2] + b[3]));
    s += __shfl_xor(s, 16); s += __shfl_xor(s, 32);
    return s * INV_D + RMS_EPS;
}
struct EpiSwiGLU {
    static constexpr bool PERM = true, AFTER_DRAIN = false, LDS_SCALES = false;
    bf16_t* H; int ldh; const float* ss;
    __device__ __forceinline__ void operator()(const f32x4 (&acc)[2][2][4][2], const Unit& u, int wr, int wc, int fr, int fq) const {
        const int row0 = u.pm * BM + wr * 64 + fr, col0 = u.pn * HALF + wc * 32 + 8 * fq;
#ifdef DUP_EPI
        for (int rep_ = 0; rep_ < DUP_EPI; ++rep_)
#endif
#pragma unroll
        for (int ai = 0; ai < 2; ++ai)
#pragma unroll
            for (int m = 0; m < 4; ++m) { const int row = row0 + ai * HALF + m * 16; const float v = row_msq(ss, row, fq), c1 = -1.4426950408889634f * __builtin_amdgcn_rsqf(v);
                const f32x2 vv = (f32x2){v, v}, cc = (f32x2){c1, c1};
                unsigned w[4]; f32x2 g[4], up[4], e[4], r[4];
#pragma unroll
                for (int q = 0; q < 4; ++q) { g[q] = (f32x2){acc[ai][0][m][q >> 1][2 * (q & 1)], acc[ai][0][m][q >> 1][2 * (q & 1) + 1]}; up[q] = (f32x2){acc[ai][1][m][q >> 1][2 * (q & 1)], acc[ai][1][m][q >> 1][2 * (q & 1) + 1]}; }
#pragma unroll
                for (int q = 0; q < 4; ++q) { const f32x2 ea = g[q] * cc; e[q].x = __builtin_amdgcn_exp2f(ea.x); e[q].y = __builtin_amdgcn_exp2f(ea.y); }
#pragma unroll
                for (int q = 0; q < 4; ++q) { const f32x2 den = e[q] * vv + vv; r[q].x = __builtin_amdgcn_rcpf(den.x); r[q].y = __builtin_amdgcn_rcpf(den.y); }
#pragma unroll
                for (int q = 0; q < 4; ++q) { const f32x2 hv = (g[q] * up[q]) * r[q]; w[q] = cvt_pk_bf16(hv.x, hv.y); }
                u32x4 o; o.x = w[0]; o.y = w[1]; o.z = w[2]; o.w = w[3];
                *(u32x4*)(H + (size_t)row * ldh + col0) = o; }
    }
};
struct EpiScaleBf16 {
    static constexpr bool PERM = true, AFTER_DRAIN = false, LDS_SCALES = false;
    bf16_t* Z; int ldz; const float* rsd; float csq, cso; int qtiles;
    __device__ __forceinline__ void operator()(const f32x4 (&acc)[2][2][4][2], const Unit& u, int wr, int wc, int fr, int fq) const {
        const int row0 = u.pm * BM + wr * 64 + fr, col0 = u.pn * BM + wc * 32 + 8 * fq;
        const float cs = (qtiles && (u.pn % 18) < 6) ? csq : cso;
#pragma unroll
        for (int ai = 0; ai < 2; ++ai)
#pragma unroll
            for (int m = 0; m < 4; ++m) { const int row = row0 + ai * HALF + m * 16; const float rs = rsd[row] * cs;
#pragma unroll
                for (int bj = 0; bj < 2; ++bj) { const f32x4 v0 = acc[ai][bj][m][0] * rs, v1 = acc[ai][bj][m][1] * rs;
                    u32x4 o; o.x = cvt_pk_bf16(v0[0], v0[1]); o.y = cvt_pk_bf16(v0[2], v0[3]); o.z = cvt_pk_bf16(v1[0], v1[1]); o.w = cvt_pk_bf16(v1[2], v1[3]);
                    *(u32x4*)(Z + (size_t)row * ldz + col0 + bj * HALF) = o; } }
    }
};
__device__ __forceinline__ f32x4 i2f4(f32x4 a) { const i32x4_ i = __builtin_bit_cast(i32x4_, a); return (f32x4){(float)i[0], (float)i[1], (float)i[2], (float)i[3]}; }
struct EpiScaleI8 {
    static constexpr bool PERM = true, AFTER_DRAIN = false, LDS_SCALES = true;
    bf16_t* Z; int ldz; const float* sbase; unsigned row_off, col_off; float csq, cso;
    __device__ __forceinline__ void operator()(const f32x4 (&acc)[2][2][4][2], const Unit& u, int wr, int wc, int fr, int fq, const PG8_LAS float* lsc) const {
        const int row0 = u.pm * BM + wr * 64 + fr, col0 = u.pn * BM + wc * 32 + 8 * fq;
        const float cs = ((u.pn < 54 && (u.pn % 18) < 6) ? csq : cso) * (1.0f / 127.0f);
        f32x4 cb[2][2];
#pragma unroll
        for (int bj = 0; bj < 2; ++bj)
#pragma unroll
            for (int n = 0; n < 2; ++n) cb[bj][n] = *(const PG8_LAS f32x4*)(lsc + 256 + wc * 32 + 8 * fq + bj * HALF + 4 * n) * cs;
#pragma unroll
        for (int ai = 0; ai < 2; ++ai)
#pragma unroll
            for (int m = 0; m < 4; ++m) { const int row = row0 + ai * HALF + m * 16; const float rs = lsc[ai * HALF + wr * 64 + m * 16 + fr];
#pragma unroll
                for (int bj = 0; bj < 2; ++bj) { const f32x4 v0 = i2f4(acc[ai][bj][m][0]) * cb[bj][0] * rs, v1 = i2f4(acc[ai][bj][m][1]) * cb[bj][1] * rs;
                    u32x4 o; o.x = cvt_pk_bf16(v0[0], v0[1]); o.y = cvt_pk_bf16(v0[2], v0[3]); o.z = cvt_pk_bf16(v1[0], v1[1]); o.w = cvt_pk_bf16(v1[2], v1[3]);
                    *(u32x4*)(Z + (size_t)row * ldz + col0 + bj * HALF) = o; } }
    }
};
struct EpiSwiGLUI8 {
    static constexpr bool PERM = true, AFTER_DRAIN = false, LDS_SCALES = true;
    bf16_t* H; int ldh; const float* sbase; unsigned row_off, col_off;
    __device__ __forceinline__ void operator()(const f32x4 (&acc)[2][2][4][2], const Unit& u, int wr, int wc, int fr, int fq, const PG8_LAS float* lsc) const {
        const int row0 = u.pm * BM + wr * 64 + fr, col0 = u.pn * HALF + wc * 32 + 8 * fq;
        f32x2 cg[4], cu[4];
        { const PG8_LAS float* lc = lsc + 256 + wc * 32 + 8 * fq;
          const f32x4 g0 = *(const PG8_LAS f32x4*)(lc), g1 = *(const PG8_LAS f32x4*)(lc + 4), u0 = *(const PG8_LAS f32x4*)(lc + HALF), u1 = *(const PG8_LAS f32x4*)(lc + HALF + 4);
          cg[0] = (f32x2){g0[0], g0[1]} * (1.0f / 127.0f); cg[1] = (f32x2){g0[2], g0[3]} * (1.0f / 127.0f); cg[2] = (f32x2){g1[0], g1[1]} * (1.0f / 127.0f); cg[3] = (f32x2){g1[2], g1[3]} * (1.0f / 127.0f);
          cu[0] = (f32x2){u0[0], u0[1]} * (1.0f / 127.0f); cu[1] = (f32x2){u0[2], u0[3]} * (1.0f / 127.0f); cu[2] = (f32x2){u1[0], u1[1]} * (1.0f / 127.0f); cu[3] = (f32x2){u1[2], u1[3]} * (1.0f / 127.0f); }
#pragma unroll
        for (int ai = 0; ai < 2; ++ai)
#pragma unroll
            for (int m = 0; m < 4; ++m) { const int row = row0 + ai * HALF + m * 16; const float a = lsc[ai * HALF + wr * 64 + m * 16 + fr];
                const f32x2 aa = (f32x2){a, a}, ae = (f32x2){a * -1.4426950408889634f, a * -1.4426950408889634f};
                unsigned w[4]; f32x2 gf[4], uf[4], G[4], e[4], r[4];
#pragma unroll
                for (int q = 0; q < 4; ++q) { const i32x4_ gi = __builtin_bit_cast(i32x4_, acc[ai][0][m][q >> 1]), ui = __builtin_bit_cast(i32x4_, acc[ai][1][m][q >> 1]);
                    gf[q] = (f32x2){(float)gi[2 * (q & 1)], (float)gi[2 * (q & 1) + 1]} * cg[q]; uf[q] = (f32x2){(float)ui[2 * (q & 1)], (float)ui[2 * (q & 1) + 1]} * cu[q]; }
#pragma unroll
                for (int q = 0; q < 4; ++q) { const f32x2 ea = gf[q] * ae; e[q].x = __builtin_amdgcn_exp2f(ea.x); e[q].y = __builtin_amdgcn_exp2f(ea.y); G[q] = gf[q] * aa; }
#pragma unroll
                for (int q = 0; q < 4; ++q) { const f32x2 den = e[q] + 1.0f; r[q].x = __builtin_amdgcn_rcpf(den.x); r[q].y = __builtin_amdgcn_rcpf(den.y); }
#pragma unroll
                for (int q = 0; q < 4; ++q) { const f32x2 hv = (G[q] * (uf[q] * aa)) * r[q]; w[q] = cvt_pk_bf16(hv.x, hv.y); }
                u32x4 o; o.x = w[0]; o.y = w[1]; o.z = w[2]; o.w = w[3];
                *(u32x4*)(H + (size_t)row * ldh + col0) = o; }
    }
};
struct EpiResidual {
    static constexpr bool PERM = true, AFTER_DRAIN = false, LDS_SCALES = false;
    bf16_t* xb; float* ssn; float sc; unsigned char* x8; bf16_t* xw;
    __device__ __forceinline__ void operator()(const f32x4 (&acc)[2][2][4][2], const Unit& u, int wr, int wc, int fr, int fq) const {
        const int row0 = u.pm * BM + wr * 64 + fr, col0 = u.pn * BM + wc * 32 + 8 * fq;
#pragma unroll
        for (int ai = 0; ai < 2; ++ai) {
            u32x4 xv[4][2];
#pragma unroll
            for (int m = 0; m < 4; ++m) { const size_t off = (size_t)(row0 + ai * HALF + m * 16) * 2048 + col0;
#pragma unroll
                for (int bj = 0; bj < 2; ++bj) xv[m][bj] = *(const u32x4*)(xb + off + bj * HALF); }
#pragma unroll
            for (int m = 0; m < 4; ++m) { const int row = row0 + ai * HALF + m * 16; const size_t off = (size_t)row * 2048 + col0; float q = 0.f;
#pragma unroll
                for (int bj = 0; bj < 2; ++bj) { const u32x4 xo = xv[m][bj]; const f32x4 d0 = acc[ai][bj][m][0] * sc, d1 = acc[ai][bj][m][1] * sc;
                    const float a0 = __uint_as_float(xo[0] << 16) + d0[0], a1 = __uint_as_float(xo[0] & 0xffff0000u) + d0[1], a2 = __uint_as_float(xo[1] << 16) + d0[2], a3 = __uint_as_float(xo[1] & 0xffff0000u) + d0[3];
                    const float b0 = __uint_as_float(xo[2] << 16) + d1[0], b1 = __uint_as_float(xo[2] & 0xffff0000u) + d1[1], b2 = __uint_as_float(xo[3] << 16) + d1[2], b3 = __uint_as_float(xo[3] & 0xffff0000u) + d1[3];
                    u32x4 o; o.x = cvt_pk_bf16(a0, a1); o.y = cvt_pk_bf16(a2, a3); o.z = cvt_pk_bf16(b0, b1); o.w = cvt_pk_bf16(b2, b3);
                    *(u32x4*)(xw + off + bj * HALF) = o;
                    if (x8) { u32x2_ e; e.x = __builtin_amdgcn_cvt_pk_fp8_f32(a0, a1, 0, false); e.x = __builtin_amdgcn_cvt_pk_fp8_f32(a2, a3, e.x, true);
                        e.y = __builtin_amdgcn_cvt_pk_fp8_f32(b0, b1, 0, false); e.y = __builtin_amdgcn_cvt_pk_fp8_f32(b2, b3, e.y, true); *(u32x2_*)(x8 + off + bj * HALF) = e; }
                    q += (a0 * a0 + a1 * a1) + (a2 * a2 + a3 * a3) + (b0 * b0 + b1 * b1) + (b2 * b2 + b3 * b3); }
                q += __shfl_xor(q, 16); q += __shfl_xor(q, 32);
                if (fq == 0) ssn[(size_t)row * 32 + u.pn * 4 + wc] = q; }
            asm volatile("" ::: "memory"); }
    }
};
template <class Epi, class Sched, bool ALIGN_EPI = false, bool SP2 = false, int ESZ = 2>
__device__ __forceinline__ void gemm_phase(PG8_LAS unsigned char* lds, const Gemm g, const Sched& S, const Epi& E, int wv  ) {
    constexpr bool B_BLOCKED = (PG8_B_BLOCKED != 0) && Epi::PERM;
    int tid_ = (wv << 6) | lane_id_fresh(); asm volatile("" : "+v"(tid_));
    const int tid = tid_, wid = __builtin_amdgcn_readfirstlane(tid >> 6), lane = tid & 63, wr = wid >> 2, wc = wid & 3, fr = lane & 15, fq = lane >> 4;
    const int K = g.K, Kb = K * (ESZ == 2 ? 2 : 1)  , nt = Kb / (BK * 2);
    unsigned voffA[2], voffB[2];
#pragma unroll
    for (int i = 0; i < 2; ++i) { int R, C; stage_rc(tid * 16 + i * 8192, R, C); const int Rb = Epi::PERM ? ((R & ~31) + perm32(R & 31)) : R;
        voffA[i] = (unsigned)(R * Kb + C * 2);
        if constexpr (B_BLOCKED) { const int b_ = tid * 16 + i * 8192, st_ = b_ >> 10; (void)Rb; voffB[i] = (unsigned)(((st_ >> 1) * (Kb >> 6) + (st_ & 1)) * 1024 + (b_ & 1023)); }
        else voffB[i] = (unsigned)(Rb * Kb + C * 2); }
    const unsigned kstep = (unsigned)(BK * 2);
    const unsigned kstepB = B_BLOCKED ? 2048u : kstep;
    const unsigned hstep = (unsigned)HALF * (unsigned)Kb;
    const unsigned tstep = 2u * hstep;
    const unsigned ldsw = (unsigned)wid * 1024u;
    const int aoff = lds_byte(wr * 64 + fr, fq * 8), boff = lds_byte(wc * 32 + fr, fq * 8);
#define PG8_SA(b, h) (((b) * 2 + (h)) * HTB)
#define PG8_SB(b, h) ((4 + (b) * 2 + (h)) * HTB)
#define PG8_STAGE(bufoff, rsrc, soff, voff) do { _Pragma("unroll") for (int _i = 0; _i < 2; ++_i) \
        __builtin_amdgcn_raw_ptr_buffer_load_lds((rsrc), (PG8_LAS void*)(lds + (bufoff) + ldsw + _i * 8192), 16, (int)(voff)[_i], (int)(soff), 0, 0); } while (0)
#define PG8_LDA(dst, b, h) do { _Pragma("unroll") for (int m = 0; m < 4; ++m) _Pragma("unroll") for (int k = 0; k < 2; ++k) dst[m][k] = *(const PG8_LAS bf16x8*)(lds + PG8_SA(b, h) + aoff + m * 2048 + k * 1024); } while (0)
#define PG8_LDB(dst, b, h) do { _Pragma("unroll") for (int n = 0; n < 2; ++n) _Pragma("unroll") for (int k = 0; k < 2; ++k) dst[n][k] = *(const PG8_LAS bf16x8*)(lds + PG8_SB(b, h) + boff + n * 2048 + k * 1024); } while (0)
#define PG8_MMA(ai, bj, At, Bt) do { __builtin_amdgcn_s_setprio(1); \
        if constexpr (ESZ == 2) { _Pragma("unroll") for (int m = 0; m < 4; ++m) _Pragma("unroll") for (int n = 0; n < 2; ++n) _Pragma("unroll") for (int k = 0; k < 2; ++k) \
            acc[ai][bj][m][n] = __builtin_amdgcn_mfma_f32_16x16x32_bf16(Bt[n][k], At[m][k], acc[ai][bj][m][n], 0, 0, 0); } \
        else if constexpr (ESZ == 3) { _Pragma("unroll") for (int m = 0; m < 4; ++m) _Pragma("unroll") for (int n = 0; n < 2; ++n) _Pragma("unroll") for (int k = 0; k < 2; ++k) \
            acc[ai][bj][m][n] = __builtin_bit_cast(f32x4, __builtin_amdgcn_mfma_i32_16x16x64_i8(__builtin_bit_cast(i32x4_, Bt[n][k]), __builtin_bit_cast(i32x4_, At[m][k]), __builtin_bit_cast(i32x4_, acc[ai][bj][m][n]), 0, 0, 0)); } \
        else { _Pragma("unroll") for (int m = 0; m < 4; ++m) _Pragma("unroll") for (int n = 0; n < 2; ++n) { \
            const i32x8 b8_ = __builtin_shufflevector(__builtin_bit_cast(i32x4_, Bt[n][0]), __builtin_bit_cast(i32x4_, Bt[n][1]), 0, 1, 2, 3, 4, 5, 6, 7); \
            const i32x8 a8_ = __builtin_shufflevector(__builtin_bit_cast(i32x4_, At[m][0]), __builtin_bit_cast(i32x4_, At[m][1]), 0, 1, 2, 3, 4, 5, 6, 7); \
            asm volatile("v_mfma_scale_f32_16x16x128_f8f6f4 %0, %1, %2, %0, %3, %3 op_sel_hi:[0,0,0]" : "+v"(acc[ai][bj][m][n]) : "v"(b8_), "v"(a8_), "v"(one8_)); } } \
        __builtin_amdgcn_s_setprio(0); } while (0)
#define PG8_WAIT_V(n) asm volatile("s_waitcnt vmcnt(" #n ")" ::: "memory")
#define PG8_WAIT_L(n) asm volatile("s_waitcnt lgkmcnt(" #n ")" ::: "memory")
#define PG8_BAR __builtin_amdgcn_s_barrier()
#define PG8_SCHED __builtin_amdgcn_sched_barrier(0)
    const int one8_ = 0x7f7f7f7f;
    Unit cur, nxt; int ui = 0;
    if (!S.next(0, cur)) return;
    f32x4 acc[2][2][4][2];
#pragma unroll
    for (int a = 0; a < 2; ++a)
#pragma unroll
        for (int b = 0; b < 2; ++b)
#pragma unroll
            for (int m = 0; m < 4; ++m)
#pragma unroll
                for (int n = 0; n < 2; ++n) { typedef double f64x2_ __attribute__((ext_vector_type(2))); f64x2_ z_; asm volatile("v_mov_b64 %0, 0" : "=v"(z_.x)); asm volatile("v_mov_b64 %0, 0" : "=v"(z_.y)); acc[a][b][m][n] = __builtin_bit_cast(f32x4, z_); }
    bf16x8 At[4][2], B0[2][2], B1[2][2];
    const __amdgpu_buffer_rsrc_t rA = __builtin_amdgcn_make_buffer_rsrc((void*)g.A, 0, (int)((unsigned)g.M * (unsigned)Kb), 0x00020000), rB = __builtin_amdgcn_make_buffer_rsrc((void*)g.Bt, 0, (int)((unsigned)g.N * (unsigned)Kb), 0x00020000);
    unsigned cA = (unsigned)cur.pm * tstep, cB = (unsigned)cur.pn * tstep;
    __amdgpu_buffer_rsrc_t rS = rA; unsigned voffS = 0;
    if constexpr (Epi::LDS_SCALES) { rS = __builtin_amdgcn_make_buffer_rsrc((void*)E.sbase, 0, 1 << 24, 0x00020000); voffS = (unsigned)(lane * 4 + (wid & 3) * 256); }
    S.a_ready(cur);
    if constexpr (SP2) {
        PG8_STAGE(PG8_SB(0, 0), rB, cB, voffB); PG8_STAGE(PG8_SB(0, 1), rB, cB + hstep, voffB); PG8_STAGE(PG8_SA(0, 0), rA, cA, voffA); PG8_STAGE(PG8_SA(0, 1), rA, cA + hstep, voffA);
        if (wr == 1) PG8_BAR;
        PG8_WAIT_V(2); PG8_BAR;
        PG8_STAGE(PG8_SB(1, 0), rB, cB + kstepB, voffB); PG8_STAGE(PG8_SA(1, 0), rA, cA + kstep, voffA); PG8_STAGE(PG8_SB(1, 1), rB, cB + hstep + kstepB, voffB);
        PG8_WAIT_V(6); PG8_BAR;
    } else {
        PG8_STAGE(PG8_SB(0, 0), rB, cB, voffB); PG8_STAGE(PG8_SA(0, 0), rA, cA, voffA); PG8_STAGE(PG8_SB(0, 1), rB, cB + hstep, voffB); PG8_STAGE(PG8_SA(0, 1), rA, cA + hstep, voffA);
        if (wr == 1) PG8_BAR;
        PG8_WAIT_V(4); PG8_BAR;
        PG8_STAGE(PG8_SB(1, 0), rB, cB + kstepB, voffB); PG8_STAGE(PG8_SA(1, 0), rA, cA + kstep, voffA); PG8_STAGE(PG8_SB(1, 1), rB, cB + hstep + kstepB, voffB);
        PG8_WAIT_V(6); PG8_BAR;
    }
    for (;;) {
        const bool has_next = S.next(ui + 1, nxt);
        const unsigned nA = has_next ? (unsigned)nxt.pm * tstep : cA, nB = has_next ? (unsigned)nxt.pn * tstep : cB;
        for (int t = 0; t < nt; t += 2) {
            const bool last = (t == nt - 2);
            const unsigned a1 = cA + (unsigned)(t + 1) * kstep;
            const unsigned a2 = last ? nA : cA + (unsigned)(t + 2) * kstep, b2 = last ? nB : cB + (unsigned)(t + 2) * kstepB;
            const unsigned a3 = a2 + kstep, b3 = b2 + kstepB;
            if (last && has_next) S.a_ready(nxt);
            if constexpr (Epi::LDS_SCALES) { if (last) {
                const unsigned so_ = (wid < 4) ? E.row_off + (unsigned)cur.pm * 1024u : E.col_off + (unsigned)cur.pn * 1024u;
                __builtin_amdgcn_raw_ptr_buffer_load_lds(rS, (PG8_LAS void*)(lds + 131072 + wid * 256), 4, (int)voffS, (int)so_, 0, 0); } }
            if constexpr (SP2) {
            PG8_LDB(B0, 0, 0); PG8_LDB(B1, 0, 1); PG8_SCHED; PG8_LDA(At, 0, 0); PG8_STAGE(PG8_SA(1, 1), rA, a1 + hstep, voffA);
            PG8_WAIT_V(8); PG8_WAIT_L(0); PG8_BAR; PG8_MMA(0, 0, At, B0); PG8_MMA(0, 1, At, B1); PG8_BAR; PG8_SCHED;
            PG8_LDA(At, 0, 1); PG8_STAGE(PG8_SB(0, 0), rB, b2, voffB); PG8_STAGE(PG8_SB(0, 1), rB, b2 + hstep, voffB); PG8_STAGE(PG8_SA(0, 0), rA, a2, voffA);
            PG8_WAIT_V(8); PG8_WAIT_L(0); PG8_BAR; PG8_MMA(1, 0, At, B0); PG8_MMA(1, 1, At, B1); PG8_BAR; PG8_SCHED;
            PG8_LDB(B0, 1, 0); PG8_LDB(B1, 1, 1); PG8_SCHED; PG8_LDA(At, 1, 0); PG8_STAGE(PG8_SA(0, 1), rA, a2 + hstep, voffA);
            PG8_WAIT_V(8); PG8_WAIT_L(0); PG8_BAR; PG8_MMA(0, 0, At, B0); PG8_MMA(0, 1, At, B1); PG8_BAR; PG8_SCHED;
            PG8_LDA(At, 1, 1); PG8_STAGE(PG8_SB(1, 0), rB, b3, voffB); PG8_STAGE(PG8_SB(1, 1), rB, b3 + hstep, voffB); PG8_STAGE(PG8_SA(1, 0), rA, a3, voffA);
            PG8_WAIT_V(8); PG8_WAIT_L(0); PG8_BAR; PG8_MMA(1, 0, At, B0); PG8_MMA(1, 1, At, B1); PG8_BAR; PG8_SCHED;
            } else {
            PG8_LDB(B0, 0, 0); PG8_SCHED; PG8_LDA(At, 0, 0); PG8_STAGE(PG8_SA(1, 1), rA, a1 + hstep, voffA);
            PG8_WAIT_L(8); PG8_BAR; PG8_WAIT_L(0); PG8_MMA(0, 0, At, B0); PG8_BAR; PG8_SCHED;
            PG8_LDB(B1, 0, 1); PG8_STAGE(PG8_SB(0, 0), rB, b2, voffB);
            PG8_BAR; PG8_WAIT_L(0); PG8_MMA(0, 1, At, B1); PG8_BAR;
            PG8_LDA(At, 0, 1); PG8_STAGE(PG8_SA(0, 0), rA, a2, voffA);
            PG8_BAR; PG8_WAIT_L(0); PG8_MMA(1, 0, At, B0); PG8_BAR; PG8_SCHED;
            PG8_STAGE(PG8_SB(0, 1), rB, b2 + hstep, voffB);
            PG8_WAIT_V(6); PG8_BAR; PG8_MMA(1, 1, At, B1); PG8_BAR;
            PG8_LDB(B0, 1, 0); PG8_SCHED; PG8_LDA(At, 1, 0); PG8_STAGE(PG8_SA(0, 1), rA, a2 + hstep, voffA);
            PG8_WAIT_L(8); PG8_BAR; PG8_WAIT_L(0); PG8_MMA(0, 0, At, B0); PG8_BAR; PG8_SCHED;
            PG8_LDB(B1, 1, 1); PG8_STAGE(PG8_SB(1, 0), rB, b3, voffB);
            PG8_BAR; PG8_WAIT_L(0); PG8_MMA(0, 1, At, B1); PG8_BAR;
            PG8_LDA(At, 1, 1); PG8_STAGE(PG8_SA(1, 0), rA, a3, voffA);
            PG8_BAR; PG8_WAIT_L(0); PG8_MMA(1, 0, At, B0); PG8_BAR; PG8_SCHED;
            PG8_STAGE(PG8_SB(1, 1), rB, b3 + hstep, voffB);
            PG8_WAIT_V(6); PG8_BAR; PG8_MMA(1, 1, At, B1); PG8_BAR;
            }
        }
        if constexpr (ESZ == 1) asm volatile("s_nop 15\n\ts_nop 15" ::: "memory");
        if constexpr (ALIGN_EPI) { if (wr == 0) PG8_BAR; }
        if constexpr (!Epi::AFTER_DRAIN) { Unit ue_ = cur; asm volatile("" : "+s"(ue_.pm), "+s"(ue_.pn));
            if constexpr (Epi::LDS_SCALES) E(acc, ue_, wr, wc, fr, fq, (const PG8_LAS float*)(lds + 131072)); else E(acc, ue_, wr, wc, fr, fq); S.done(cur); }
        if (!has_next) break;
#pragma unroll
        for (int a = 0; a < 2; ++a)
#pragma unroll
            for (int b = 0; b < 2; ++b)
#pragma unroll
                for (int m = 0; m < 4; ++m)
#pragma unroll
                    for (int n = 0; n < 2; ++n) { typedef double f64x2_ __attribute__((ext_vector_type(2))); f64x2_ z_; asm volatile("v_mov_b64 %0, 0" : "=v"(z_.x)); asm volatile("v_mov_b64 %0, 0" : "=v"(z_.y)); acc[a][b][m][n] = __builtin_bit_cast(f32x4, z_); }
        cur = nxt; cA = nA; cB = nB; ++ui;
        if constexpr (ALIGN_EPI) { if (wr == 1) PG8_BAR; }
    }
    PG8_WAIT_V(0);
    if constexpr (!ALIGN_EPI) { if (wr == 0) PG8_BAR; }
    PG8_BAR;
    if constexpr (Epi::AFTER_DRAIN) { E.fused(acc, cur, wr, wc, fr, fq, lds, wid, lane); S.done(cur); }
#undef PG8_SA
#undef PG8_SB
#undef PG8_STAGE
#undef PG8_LDA
#undef PG8_LDB
#undef PG8_MMA
#undef PG8_WAIT_V
#undef PG8_WAIT_L
#undef PG8_BAR
#undef PG8_SCHED
}
}
#define LAS __attribute__((address_space(3)))
#define XB_TMO      128
#define XB_XCNT(j)  (256  + 64 * (j))
#define XB_XSUB(j)  (1280 + 64 * (j))
#define XB_XGEN(j)  (2304 + 64 * (j))
#define XB_TOP      3328
#define XB_TOPGEN   3392
#define XCD_BAR_WORDS 3456
#define XB_SPIN_CAP (1u << 18)

__device__ __forceinline__ unsigned xb_ld(unsigned* p)              { return __hip_atomic_load(p, __ATOMIC_RELAXED, __HIP_MEMORY_SCOPE_AGENT); }
__device__ __forceinline__ unsigned xb_add(unsigned* p, unsigned v) { return __hip_atomic_fetch_add(p, v, __ATOMIC_RELAXED, __HIP_MEMORY_SCOPE_AGENT); }
__device__ __forceinline__ unsigned xb_xcc_id() { return (unsigned)__builtin_amdgcn_s_getreg((3 << 11) | 20) & 0xFu; }
#define XB_SPIN(cond, bar) do { unsigned _sp = 0; while (cond) { __builtin_amdgcn_s_sleep(1); \
    if ((++_sp & 255u) == 0u) { if (xb_ld(&(bar)[XB_TMO])) break; if (_sp > XB_SPIN_CAP) { atomicAdd(&(bar)[XB_TMO], 1u); break; } } } } while (0)

struct XcdBarrier {
    unsigned* bar; unsigned x; unsigned wv;
    volatile LAS unsigned* st;
};

__device__ __forceinline__ unsigned xb_lane() { return (unsigned)pg8::lane_id_fresh(); }
__device__ __forceinline__ XcdBarrier xcd_barrier_post(unsigned* bar, volatile LAS unsigned* st) {
    XcdBarrier b; b.bar = bar; b.x = xb_xcc_id(); b.st = st; b.wv = (unsigned)__builtin_amdgcn_readfirstlane((int)(threadIdx.x >> 6));
    if (threadIdx.x == 0) (void)xb_add(&bar[XB_XCNT(b.x)], 1u);
    return b;
}
__device__ __forceinline__ void xcd_barrier_complete(unsigned* bar, unsigned x, unsigned& nloc, unsigned& nx) {
    const unsigned G = gridDim.x * gridDim.y * gridDim.z;
    unsigned sum, cnt, mine, sp = 0u;
    for (;;) {
        sum = 0u; cnt = 0u; mine = 0u;
#pragma unroll
        for (unsigned j = 0; j < 16; ++j) { const unsigned c = xb_ld(&bar[XB_XCNT(j)]); sum += c; cnt += (c > 0u) ? 1u : 0u; mine = (j == x) ? c : mine; }
        if (sum == G) break;
        __builtin_amdgcn_s_sleep(1);
        if ((++sp & 255u) == 0u) { if (xb_ld(&bar[XB_TMO])) break; if (sp > XB_SPIN_CAP) { atomicAdd(&bar[XB_TMO], 1u); break; } }
    }
    nloc = mine > 0u ? mine : 1u; nx = cnt > 0u ? cnt : 1u;
}

__device__ __forceinline__ void xcd_barrier(const XcdBarrier& b) {
    asm volatile("s_waitcnt vmcnt(0)" ::: "memory");
    __syncthreads();
    if (b.wv == 0u && xb_lane() == 0u) {
        unsigned* bar = b.bar;
        __builtin_amdgcn_s_waitcnt(0);
        unsigned nloc = b.st[0], nx = b.st[1];
        if (nloc == 0u) { xcd_barrier_complete(bar, b.x, nloc, nx); b.st[0] = nloc; b.st[1] = nx; }
        const unsigned old = xb_add(&bar[XB_XSUB(b.x)], 1u);
        const unsigned gen = old / nloc;
        if (old + 1u == (gen + 1u) * nloc) {
            __builtin_amdgcn_fence(__ATOMIC_RELEASE, "agent");
            asm volatile("s_waitcnt vmcnt(0)" ::: "memory");
            const unsigned og = xb_add(&bar[XB_TOP], 1u);
            const unsigned tg = og / nx;
            if (og + 1u == (tg + 1u) * nx) xb_add(&bar[XB_TOPGEN], 1u);
            else XB_SPIN(xb_ld(&bar[XB_TOPGEN]) == tg, bar);
            __builtin_amdgcn_fence(__ATOMIC_ACQUIRE, "agent");
            xb_add(&bar[XB_XGEN(b.x)], 1u);
            asm volatile("s_waitcnt vmcnt(0)" ::: "memory");
        } else {
            XB_SPIN(xb_ld(&bar[XB_XGEN(b.x)]) == gen, bar);
            __builtin_amdgcn_fence(__ATOMIC_ACQUIRE, "agent");
            asm volatile("s_waitcnt vmcnt(0)" ::: "memory");
        }
    }
    __syncthreads();
}
constexpr int DM = 2048, DFF = 5632, SEQ = 2048, DEPTH = 4, NSEQ = 24, NTOK = NSEQ * SEQ;
constexpr int TC = 16384, NCHUNK = NTOK / TC;
constexpr int NH = 12, HD = 128, ATTW = 1536, QKVW = 13824, INW = 14336, POOLW = 512;
constexpr int NGU = 2 * DFF;
constexpr float LOG2E = 1.4426950408889634f;
constexpr float QSCALE = 0.08838834764831845f * LOG2E;
constexpr int NSTEPS = 1 + NCHUNK * DEPTH * 8 + 1;

constexpr size_t MiB = 1u << 20;
constexpr size_t WS_CTL = 0, WS_CM = 1 * MiB, CTL_ZERO_BYTES = 2 * MiB;
constexpr int CM_IN = 0, CM_GU = 65536;
static_assert(DEPTH * 14336 <= CM_GU && (size_t)(CM_GU + 2 * DEPTH * 11264) * 4 <= 1 * MiB, "column-maxima map");
#ifndef DUP_GU8
#define DUP_GU8 1
#endif
#ifndef DUP_IN8
#define DUP_IN8 1
#endif
#ifndef ATT_SPLIT
#define ATT_SPLIT 1024
#endif
#ifndef I8_POOLIN
#define I8_POOLIN 0
#endif
#ifndef I8GU_MASK
#define I8GU_MASK 0xFFu
#endif
constexpr size_t WS_SR = 4 * MiB + 512 * 1024;
constexpr size_t WS_SA = 4 * MiB + 256 * 1024;
constexpr size_t WS_LUT = 4 * MiB, WS_WPT = 5 * MiB, WS_LSE = 6 * MiB;
constexpr size_t WS_W = 16 * MiB, W_LAYER = 196 * MiB;
constexpr size_t WO_GU0 = 0, WO_GU1 = 44 * MiB, WO_D0 = 88 * MiB, WO_D1 = 110 * MiB, WO_IN = 132 * MiB  , WO_INU = 160 * MiB  , WO_OUT = 188 * MiB;
constexpr float W8_SCALE = 64.0f;
constexpr size_t WS_XB = 800 * MiB, WS_H = 992 * MiB, WS_OG = WS_H, WS_Z = 1168 * MiB, WS_MIX = 1616 * MiB, WS_SS = 1680 * MiB, WS_XB8 = 1760 * MiB, WS_END = 1856 * MiB;
static_assert((size_t)NGU * DM * 2 == 44 * MiB && (size_t)DM * DFF * 2 == 22 * MiB && (size_t)INW * DM * 2 == 56 * MiB && (size_t)DM * DM * 2 == 8 * MiB, "weight map");
static_assert((size_t)NTOK * DM * 2 == 192 * MiB && (size_t)TC * DFF * 2 == 176 * MiB && (size_t)TC * INW * 2 == 448 * MiB && (size_t)TC * DM * 2 == 64 * MiB && (size_t)TC * 3 * ATTW * 2 <= 176 * MiB, "activation map");
static_assert(13 * (size_t)NTOK * 32 * 4 <= 80 * MiB && (size_t)TC * 36 * 4 <= 10 * MiB, "small buffers");
constexpr int CW_BAR = 4096;

constexpr int LDS_BYTES = 147456;
constexpr int ATT_K = 0, ATT_KP = 272, ATT_V = 256 * ATT_KP, ATT_VP = 288, ATT_LUT = ATT_V + 256 * ATT_VP;
constexpr int MISC_OFF = 146432;
static_assert(ATT_LUT + 768 <= MISC_OFF && MISC_OFF + 64 <= LDS_BYTES, "LDS map");

#define GAS __attribute__((address_space(1)))
typedef unsigned short bf16;
typedef unsigned u32x4 __attribute__((ext_vector_type(4)));
typedef unsigned u32x2 __attribute__((ext_vector_type(2)));
typedef float f32x4 __attribute__((ext_vector_type(4)));
typedef short bf16x8 __attribute__((ext_vector_type(8)));
typedef short s16x4 __attribute__((ext_vector_type(4)));
using pg8::cvt_pk_bf16;
#define LDS_WAIT() asm volatile("s_waitcnt lgkmcnt(0)" ::: "memory")
#define LDS_BARRIER() asm volatile("s_waitcnt lgkmcnt(0)\n\ts_barrier" ::: "memory")
__device__ __forceinline__ float bf_lo(unsigned w) { return __uint_as_float(w << 16); }
__device__ __forceinline__ float bf_hi(unsigned w) { return __uint_as_float(w & 0xffff0000u); }
__device__ __forceinline__ float wave_sum(float v) {
#pragma unroll
    for (int o = 1; o < 64; o <<= 1) v += __shfl_xor(v, o);
    return v;
}

#define W_OFF(n, kb, Kb) (PG8_B_BLOCKED ? pg8::bblk_off((n), (kb), (Kb)) : ((size_t)(n) * (size_t)(Kb) + (size_t)(kb)))
struct CvtItem { const float* src; const float* gk; unsigned char* dst; float* cm; int ldn, k0, c0, ldk, r0, fp8  ; float cs; };
__device__ __forceinline__ void cvt_colmax(const CvtItem& I, const float (&lv)[32], int lane) {
    float m = 0.f;
#pragma unroll
    for (int i = 0; i < 32; ++i) { const int kk = 2 * i + (lane >> 5); m = fmaxf(m, fabsf(lv[i] * (I.gk ? I.gk[I.k0 + kk] : 1.0f))); }
    m = fmaxf(m, __shfl_xor(m, 32));
    if (lane < 32) atomicMax((unsigned*)(I.cm + I.r0 + lane), __float_as_uint(m));
}
__device__ __forceinline__ void cvt_load(const CvtItem& I, float (&lv)[32], int lane) {
#pragma unroll
    for (int i = 0; i < 32; ++i) { const int kk = 2 * i + (lane >> 5); lv[i] = I.src[(size_t)(I.k0 + kk) * I.ldn + I.c0 + (lane & 31)]; }
}
__device__ __forceinline__ void cvt_store(const CvtItem& I, const float (&lv)[32], LAS float* scr, int lane) {
#pragma unroll
    for (int i = 0; i < 32; ++i) { const int kk = 2 * i + (lane >> 5); scr[kk * 33 + (lane & 31)] = lv[i]; }
    const int c = lane & 7;
    float gs[8];
#pragma unroll
    for (int j = 0; j < 8; ++j) gs[j] = I.gk ? I.gk[I.k0 + 8 * c + j] * I.cs : I.cs;
    LDS_WAIT(); asm volatile("" ::: "memory");
#pragma unroll
    for (int j = 0; j < 4; ++j) { const int n = (lane >> 3) + 8 * j; const LAS float* s = scr + (8 * c) * 33 + n;
        float v[8];
#pragma unroll
        for (int q = 0; q < 8; ++q) v[q] = s[q * 33] * gs[q];
        if (I.fp8) { const float cmv = I.cm[I.r0 + n], inv = cmv > 0.f ? 127.0f / cmv : 0.f; int q8[8];
#pragma unroll
            for (int q = 0; q < 8; ++q) { int t = (int)__builtin_rintf(v[q] * inv); t = t < -127 ? -127 : (t > 127 ? 127 : t); q8[q] = t & 0xff; }
            u32x2 o; o.x = (unsigned)q8[0] | ((unsigned)q8[1] << 8) | ((unsigned)q8[2] << 16) | ((unsigned)q8[3] << 24); o.y = (unsigned)q8[4] | ((unsigned)q8[5] << 8) | ((unsigned)q8[6] << 16) | ((unsigned)q8[7] << 24);
            *(u32x2*)(I.dst + W_OFF(I.r0 + n, I.k0 + 8 * c, I.ldk)) = o; }
        else { u32x4 o; o.x = cvt_pk_bf16(v[0], v[1]); o.y = cvt_pk_bf16(v[2], v[3]); o.z = cvt_pk_bf16(v[4], v[5]); o.w = cvt_pk_bf16(v[6], v[7]);
            *(u32x4*)(I.dst + W_OFF(I.r0 + n, (I.k0 + 8 * c) * 2, I.ldk * 2)) = o; } }
    LDS_WAIT(); asm volatile("" ::: "memory");
}
__device__ __forceinline__ void cvt_store8(const CvtItem& I, const float (&lv)[32], LAS float* scr, int lane, float cmv) {
#pragma unroll
    for (int i = 0; i < 32; ++i) { const int kk = 2 * i + (lane >> 5); scr[kk * 33 + (lane & 31)] = lv[i]; }
    const int c = lane & 7;
    float gs[8];
#pragma unroll
    for (int j = 0; j < 8; ++j) gs[j] = I.gk[I.k0 + 8 * c + j];
    LDS_WAIT(); asm volatile("" ::: "memory");
#pragma unroll
    for (int j = 0; j < 4; ++j) { const int n = (lane >> 3) + 8 * j; const LAS float* s = scr + (8 * c) * 33 + n;
        const float cmn = __shfl(cmv, n), inv = cmn > 0.f ? 127.0f / cmn : 0.f; int q8[8];
#pragma unroll
        for (int q = 0; q < 8; ++q) { int t = (int)__builtin_rintf(s[q * 33] * gs[q] * inv); t = t < -127 ? -127 : (t > 127 ? 127 : t); q8[q] = t & 0xff; }
        u32x2 o; o.x = (unsigned)q8[0] | ((unsigned)q8[1] << 8) | ((unsigned)q8[2] << 16) | ((unsigned)q8[3] << 24); o.y = (unsigned)q8[4] | ((unsigned)q8[5] << 8) | ((unsigned)q8[6] << 16) | ((unsigned)q8[7] << 24);
        *(u32x2*)(I.dst + W_OFF(I.r0 + n, I.k0 + 8 * c, I.ldk)) = o; }
    LDS_WAIT(); asm volatile("" ::: "memory");
}
__device__ __forceinline__ int t5_bucket(int rel) {
    const int n = rel < 0 ? -rel : rel; int b;
    if (n < 8) b = n; else if (n < 15) b = 8; else if (n < 27) b = 9; else if (n < 50) b = 10; else if (n < 91) b = 11; else if (n < 166) b = 12; else if (n < 305) b = 13; else if (n < 559) b = 14; else b = 15;
    return b + (rel > 0 ? 16 : 0);
}
struct Ptrs {
    const float *x_prompt, *x_sample, *norm_g, *ffn_gate, *ffn_up, *ffn_down, *w_in, *w_pool, *pool_scale, *w_out, *rel_bias, *final_g;
    float* out; unsigned char* ws;
};
__device__ __forceinline__ void prologue(const Ptrs& P, LAS unsigned char* lds, int tid, int lane, int wave, int G, int pass) {
    LAS float* scr = (LAS float*)(lds + wave * 8448);
    const int gw = blockIdx.x * 8 + wave, NGW = G * 8;
    constexpr int I_GU = 32 * 352, I_D = 88 * 64, I_IN = 32 * 448, I_OUT = 32 * 64, I_LAYER = 2 * I_GU + 2 * I_D + I_IN + I_OUT;
    auto decode = [&](int it) -> CvtItem {
        CvtItem I; const int l = it / I_LAYER; int r = it % I_LAYER;
        unsigned char* wl = P.ws + WS_W + (size_t)l * W_LAYER; I.fp8 = 0; I.cs = 1.0f; I.cm = nullptr; float* CM = (float*)(P.ws + WS_CM);
        if (r < 2 * I_GU) { const int j = r / I_GU; r %= I_GU; const int kb = r / 352, nb = r % 352, n0 = 32 * nb, pn = n0 >> 8, within = n0 & 255;
            I.src = ((within < 128) ? P.ffn_gate : P.ffn_up) + (size_t)(l * 2 + j) * DM * DFF; I.ldn = DFF; I.k0 = 64 * kb; I.c0 = 128 * pn + (within & 127);
            I.dst = wl + (j ? WO_GU1 : WO_GU0); I.ldk = DM; I.r0 = n0; I.gk = P.norm_g + (size_t)(l * 3 + 2 * j) * DM;
            if ((I8GU_MASK >> (l * 2 + j)) & 1u) { I.fp8 = 2; I.cm = CM + CM_GU + (l * 2 + j) * NGU; }
            return I; }
        r -= 2 * I_GU;
        if (r < 2 * I_D) { const int j = r / I_D; r %= I_D; const int kb = r / 64, nb = r % 64;
            I.src = P.ffn_down + (size_t)(l * 2 + j) * DFF * DM; I.ldn = DM; I.k0 = 64 * kb; I.c0 = 32 * nb; I.dst = wl + (j ? WO_D1 : WO_D0); I.ldk = DFF; I.r0 = 32 * nb; I.gk = nullptr; return I; }
        r -= 2 * I_D;
        if (r < I_IN) { const int kb = r / 448, nb = r % 448, n0 = 32 * nb;
            I.src = P.w_in + (size_t)l * DM * INW; I.ldn = INW; I.k0 = 64 * kb; I.c0 = n0; I.ldk = DM; I.gk = P.norm_g + (size_t)(l * 3 + 1) * DM;
#if I8_POOLIN
            I.dst = wl + WO_IN; I.r0 = n0; I.fp8 = 2; I.cm = CM + CM_IN + l * INW;
#else
            if (n0 < QKVW) { I.dst = wl + WO_IN; I.r0 = n0; I.fp8 = 2; I.cm = CM + CM_IN + l * INW; } else { I.dst = wl + WO_INU; I.r0 = n0 - QKVW; }
#endif
            return I; }
        r -= I_IN;
        { const int kb = r / 64, nb = r % 64;
            I.src = P.w_out + (size_t)l * DM * DM; I.ldn = DM; I.k0 = 64 * kb; I.c0 = 32 * nb; I.dst = wl + WO_OUT; I.ldk = DM; I.r0 = 32 * nb; I.gk = nullptr; return I; }
    };
    {
        LAS float* cmx = (LAS float*)(lds + 69632);
        constexpr int S_LAYER = 2 * 352 + 432;
        for (int sidx = blockIdx.x; sidx < DEPTH * S_LAYER; sidx += G) {
            const int l = sidx / S_LAYER, r = sidx % S_LAYER; int itb, kstride;
            if (r < 704) { const int j = r / 352; if (!((I8GU_MASK >> (l * 2 + j)) & 1u)) continue; itb = l * I_LAYER + j * I_GU + (r % 352); kstride = 352; }
            else { itb = l * I_LAYER + 2 * I_GU + 2 * I_D + (r - 704); kstride = 448; }
            float lv[4][32];
#pragma unroll
            for (int b = 0; b < 4; ++b) { const CvtItem I = decode(itb + (4 * wave + b) * kstride); cvt_load(I, lv[b], lane); }
            float m = 0.f;
#pragma unroll
            for (int b = 0; b < 4; ++b) { const CvtItem I = decode(itb + (4 * wave + b) * kstride);
#pragma unroll
                for (int i = 0; i < 32; ++i) { const int kk = 2 * i + (lane >> 5); m = fmaxf(m, fabsf(lv[b][i] * I.gk[I.k0 + kk])); } }
            m = fmaxf(m, __shfl_xor(m, 32));
            if (lane < 32) cmx[wave * 32 + lane] = m;
            __syncthreads();
            float cmv = 0.f;
#pragma unroll
            for (int w = 0; w < 8; ++w) cmv = fmaxf(cmv, cmx[w * 32 + (lane & 31)]);
            { const CvtItem I = decode(itb); if (wave == 0 && lane < 32) I.cm[I.r0 + lane] = cmv; }
#pragma unroll
            for (int b = 0; b < 4; ++b) { const CvtItem I = decode(itb + (4 * wave + b) * kstride); cvt_store8(I, lv[b], scr, lane, cmv); }
            __syncthreads();
        }
    }
    {
        constexpr int NIT = DEPTH * I_LAYER;
        auto next16 = [&](int it) -> int { while (it < NIT && decode(it).fp8 == 2) it += NGW; return it; };
        int itA = next16(gw), itB = (itA < NIT) ? next16(itA + NGW) : NIT; float lvA[32], lvB[32]; CvtItem curA, curB;
        if (itA < NIT) { curA = decode(itA); cvt_load(curA, lvA, lane); } else curA = decode(0);
        curB = curA; if (itB < NIT) { curB = decode(itB); cvt_load(curB, lvB, lane); }
        while (itA < NIT) {
            float lcA[32], lcB[32];
#pragma unroll
            for (int i = 0; i < 32; ++i) { lcA[i] = lvA[i]; lcB[i] = lvB[i]; }
            const int itA2 = (itB < NIT) ? next16(itB + NGW) : NIT, itB2 = (itA2 < NIT) ? next16(itA2 + NGW) : NIT; CvtItem nA = curA, nB = curB;
            if (itA2 < NIT) { nA = decode(itA2); cvt_load(nA, lvA, lane); }
            if (itB2 < NIT) { nB = decode(itB2); cvt_load(nB, lvB, lane); }
            asm volatile("" ::: "memory");
            cvt_store(curA, lcA, scr, lane);
            if (itB < NIT) cvt_store(curB, lcB, scr, lane);
            curA = nA; curB = nB; itA = itA2; itB = itB2;
        }
    }
    bf16* XB = (bf16*)(P.ws + WS_XB); float* SS = (float*)(P.ws + WS_SS);
    for (int rowa = gw; rowa < NTOK; rowa += 2 * NGW) {
        f32x4 v[2][8]; float s[2];
#pragma unroll
        for (int h = 0; h < 2; ++h) { const int row = rowa + h * NGW; s[h] = 0.f;
            if (row < NTOK) { const float* xr = (row < 16 * SEQ) ? P.x_prompt + (size_t)row * DM : P.x_sample + (size_t)(row - 16 * SEQ) * DM;
#pragma unroll
                for (int j = 0; j < 8; ++j) v[h][j] = *(const f32x4*)(xr + 4 * lane + 256 * j); }
            else {
#pragma unroll
                for (int j = 0; j < 8; ++j) v[h][j] = (f32x4){0.f, 0.f, 0.f, 0.f}; } }
#pragma unroll
        for (int h = 0; h < 2; ++h) { const int row = rowa + h * NGW; if (row >= NTOK) continue;
#pragma unroll
            for (int j = 0; j < 8; ++j) s[h] += (v[h][j][0] * v[h][j][0] + v[h][j][1] * v[h][j][1]) + (v[h][j][2] * v[h][j][2] + v[h][j][3] * v[h][j][3]);
            s[h] = wave_sum(s[h]);
#pragma unroll
            for (int j = 0; j < 8; ++j) { u32x2 o; o.x = cvt_pk_bf16(v[h][j][0], v[h][j][1]); o.y = cvt_pk_bf16(v[h][j][2], v[h][j][3]); *(u32x2*)(XB + (size_t)row * DM + 4 * lane + 256 * j) = o; }
            if (lane < 32) SS[(size_t)row * 32 + lane] = (lane == 0) ? s[h] : 0.f; }
    }
    float* LUT = (float*)(P.ws + WS_LUT);
    for (int i = blockIdx.x * 512 + tid; i < 36 * 192; i += G * 512) { const int gh = i / 192, idx = i % 192, d64 = idx - 16, g = gh / 12, dil = (g == 0) ? 1 : (g == 1 ? 4 : 16);
        LUT[i] = (d64 >= 0 && d64 <= 128) ? P.rel_bias[t5_bucket((d64 - 64) * dil) * 36 + gh] * LOG2E : -1e30f; }
    bf16* WPT = (bf16*)(P.ws + WS_WPT);
    for (int i = blockIdx.x * 512 + tid; i < DEPTH * 4 * 128 * 128; i += G * 512) { const int c = i & 127, e = (i >> 7) & 127, lg = i >> 14;
        WPT[i] = (bf16)(cvt_pk_bf16(P.w_pool[(size_t)lg * 16384 + c * 128 + e], 0.f) & 0xffffu); }
}

#ifndef QR
#define QR 4
#endif
template <bool WR> __device__ __forceinline__ void quant_rows(const bf16* __restrict__ xb, unsigned char* __restrict__ x8, float* __restrict__ sa, float* __restrict__ sr, const float* __restrict__ ssp, int lane, int wave, int G_) {
    const int gw = blockIdx.x * 8 + wave, NGW = G_ * 8;
    for (int rb = gw; rb < TC; rb += QR * NGW) {
        u32x4 v[QR][4]; float am[QR];
#pragma unroll
        for (int q = 0; q < QR; ++q) { const int row = rb + q * NGW;
#pragma unroll
            for (int j = 0; j < 4; ++j) v[q][j] = (row < TC) ? *(const u32x4*)(xb + (size_t)row * DM + 8 * lane + 512 * j) : (u32x4){0u, 0u, 0u, 0u}; }
#pragma unroll
        for (int q = 0; q < QR; ++q) { float a = 0.f;
#pragma unroll
            for (int j = 0; j < 4; ++j)
#pragma unroll
                for (int k = 0; k < 4; ++k) a = fmaxf(a, fmaxf(fabsf(bf_lo(v[q][j][k])), fabsf(bf_hi(v[q][j][k]))));
#pragma unroll
            for (int o = 1; o < 64; o <<= 1) a = fmaxf(a, __shfl_xor(a, o));
            am[q] = a; }
#pragma unroll
        for (int q = 0; q < QR; ++q) { const int row = rb + q * NGW; if (row >= TC) continue;
            const float inv = am[q] > 0.f ? 127.0f / am[q] : 0.f;
            { float sp = (lane < 32) ? ssp[(size_t)row * 32 + lane] : 0.f;
#pragma unroll
              for (int o = 1; o < 32; o <<= 1) sp += __shfl_xor(sp, o);
              const float rstd = __builtin_amdgcn_rsqf(sp * pg8::INV_D + pg8::RMS_EPS);
              if (lane == 0) { sa[row] = am[q] * (1.0f / 127.0f) * rstd; if (WR) sr[row] = rstd; } }
#pragma unroll
            for (int j = 0; j < 4; ++j) { u32x2 o; int q8[8];
#pragma unroll
                for (int k = 0; k < 4; ++k) { int t0 = (int)__builtin_rintf(bf_lo(v[q][j][k]) * inv), t1 = (int)__builtin_rintf(bf_hi(v[q][j][k]) * inv);
                    t0 = t0 < -127 ? -127 : (t0 > 127 ? 127 : t0); t1 = t1 < -127 ? -127 : (t1 > 127 ? 127 : t1); q8[2 * k] = t0 & 0xff; q8[2 * k + 1] = t1 & 0xff; }
                o.x = (unsigned)q8[0] | ((unsigned)q8[1] << 8) | ((unsigned)q8[2] << 16) | ((unsigned)q8[3] << 24); o.y = (unsigned)q8[4] | ((unsigned)q8[5] << 8) | ((unsigned)q8[6] << 16) | ((unsigned)q8[7] << 24);
                *(u32x2*)(x8 + (size_t)row * DM + 8 * lane + 512 * j) = o; } }
    }
}

struct AttnUnit { const bf16* zb; size_t tstride; int L, i0, dil, gh, tokbase, nsteps; };
template <int MODE> __device__ __forceinline__ AttnUnit attn_decode(const bf16* z, int u) {
    AttnUnit a; int bh, g, c, seg;
    if (MODE) { bh = u >> 3; g = 0; c = 0; seg = u & 7; a.dil = 1; a.nsteps = 2; }
    else if (u < 768) { bh = u >> 3; g = 1; c = (u & 7) >> 1; seg = u & 1; a.dil = 4; a.nsteps = 2; }
    else { const int v = u - 768; bh = v >> 4; g = 2; c = v & 15; seg = 0; a.dil = 16; a.nsteps = 1; }
    const int b = bh / NH, h = bh % NH;
    a.L = SEQ / a.dil; a.i0 = seg * 256; a.tstride = (size_t)a.dil * INW; a.gh = g * NH + h; a.tokbase = b * SEQ + c;
    a.zb = z + (size_t)a.tokbase * INW + g * 4608 + h * HD;
    return a;
}
struct AttnRegs { u32x4 kv[8], vv[8]; bf16x8 qf[4]; float lutv; };
__device__ __forceinline__ void attn_issue(const AttnUnit& a, int i0s, bool first, AttnRegs& R, const float* __restrict__ lutg, int tid, int lane, int wave) {
    const int kstart = i0s - 64, sb = i0s & 255;
#pragma unroll
    for (int it = 0; it < 8; ++it) { const int id = tid + 512 * it, slot = id >> 4, cc = id & 15, p = (slot - sb) & 255, ki = kstart + p;
        R.kv[it] = (u32x4){0u, 0u, 0u, 0u}; R.vv[it] = (u32x4){0u, 0u, 0u, 0u};
        if ((first || p >= 128) && ki >= 0 && ki < a.L) { const bf16* q = a.zb + (size_t)ki * a.tstride + cc * 8; R.kv[it] = *(const u32x4*)(q + 1536); R.vv[it] = *(const u32x4*)(q + 3072); } }
    const bf16* qp = a.zb + (size_t)(i0s + 16 * wave + (lane & 15)) * a.tstride + 8 * (lane >> 4);
#pragma unroll
    for (int ks = 0; ks < 4; ++ks) R.qf[ks] = *(const bf16x8*)(qp + 32 * ks);
    R.lutv = (tid < 192) ? lutg[a.gh * 192 + tid] : 0.f;
}
template <int MODE> __device__ __forceinline__ void attn_phase(const bf16* __restrict__ z, bf16* og, float* lse, bf16* __restrict__ mix, const float* __restrict__ lutg, LAS unsigned char* lds, int tid, int lane, int wave, int u0, int G_, int nunits) {
    if (u0 >= nunits) return;
    const int qi = lane & 15, G = lane >> 4;
    LAS unsigned char* Kl = lds + ATT_K; LAS unsigned char* Vl = lds + ATT_V; LAS float* lut = (LAS float*)(lds + ATT_LUT);
    int u = u0, st = 0; AttnUnit cur = attn_decode<MODE>(z, u); AttnRegs R; attn_issue(cur, cur.i0, true, R, lutg, tid, lane, wave);
#if defined(DUP_ATTX)
    int reps_left = (MODE == DUP_ATTX_MODE) ? DUP_ATTX - 1 : 0;
#endif
    for (;;) {
        const int i0s = cur.i0 + 128 * st, sb = i0s & 255; const bool first = (st == 0);
#pragma unroll
        for (int it = 0; it < 8; ++it) { const int id = tid + 512 * it, slot = id >> 4, cc = id & 15, p = (slot - sb) & 255;
            if (first || p >= 128) { *(LAS u32x4*)(Kl + slot * ATT_KP + cc * 16) = R.kv[it]; *(LAS u32x4*)(Vl + slot * ATT_VP + cc * 16) = R.vv[it]; } }
        if (tid < 192) lut[tid] = R.lutv;
        bf16x8 qf[4];
#pragma unroll
        for (int ks = 0; ks < 4; ++ks) qf[ks] = R.qf[ks];
        LDS_BARRIER();
        int un = u, stn = st + 1; AttnUnit nxt = cur; bool has_next = true;
        if (stn >= cur.nsteps) { un = u + G_; stn = 0; has_next = un < nunits;
#if defined(DUP_ATTX)
            if (!has_next && reps_left > 0) { --reps_left; un = u0; has_next = true; }
#endif
            if (has_next) nxt = attn_decode<MODE>(z, un); }
        if (has_next) attn_issue(nxt, nxt.i0 + 128 * stn, stn == 0, R, lutg, tid, lane, wave);
        asm volatile("" ::: "memory");
        const int L = cur.L, kw0 = 16 * wave, kbase = i0s - 64 + kw0;
        const size_t tokrow = (size_t)cur.tokbase + (size_t)(i0s + 16 * wave + qi) * cur.dil;
        f32x4 s[9];
        {
            const int rb = sb + kw0 + qi;
            const LAS unsigned char* kcol = Kl + 16 * G;
            bf16x8 ka[2][4];
#pragma unroll
            for (int ks = 0; ks < 4; ++ks) ka[0][ks] = *(const LAS bf16x8*)(kcol + (rb & 255) * ATT_KP + 64 * ks);
#pragma unroll
            for (int kt = 0; kt < 9; ++kt) {
                if (kt + 1 < 9) {
#pragma unroll
                    for (int ks = 0; ks < 4; ++ks) ka[(kt + 1) & 1][ks] = *(const LAS bf16x8*)(kcol + ((rb + 16 * (kt + 1)) & 255) * ATT_KP + 64 * ks); }
                f32x4 a4 = (f32x4){0.f, 0.f, 0.f, 0.f};
#pragma unroll
                for (int ks = 0; ks < 4; ++ks) a4 = __builtin_amdgcn_mfma_f32_16x16x32_bf16(ka[kt & 1][ks], qf[ks], a4, 0, 0, 0);
                s[kt] = a4; }
        }
        float m = -3.0e38f;
        {
            const LAS float* lb = lut + (4 * G - qi + 16);
            float bv[9][4];
#pragma unroll
            for (int kt = 0; kt < 9; ++kt)
#pragma unroll
                for (int rr = 0; rr < 4; ++rr) bv[kt][rr] = lb[16 * kt + rr];
#pragma unroll
            for (int kt = 0; kt < 9; ++kt) { const bool tv = (kbase + 16 * kt >= 0) && (kbase + 16 * kt < L);
#pragma unroll
                for (int rr = 0; rr < 4; ++rr) { const float v = tv ? s[kt][rr] + bv[kt][rr] : -1e30f; s[kt][rr] = v; m = fmaxf(m, v); } }
        }
        m = fmaxf(m, __shfl_xor(m, 16)); m = fmaxf(m, __shfl_xor(m, 32));
        float lsum = 0.f;
#pragma unroll
        for (int kt = 0; kt < 9; ++kt)
#pragma unroll
            for (int rr = 0; rr < 4; ++rr) { const float p = __builtin_amdgcn_exp2f(s[kt][rr] - m); s[kt][rr] = p; lsum += p; }
        lsum += __shfl_xor(lsum, 16); lsum += __shfl_xor(lsum, 32);
        u32x2 o1[8], o2[8]; float l1 = 0.f, l2 = 0.f;
        if (MODE == 1) {
            const bf16* gp = og + tokrow * (3 * ATTW) + cur.gh * HD + 4 * G;
#pragma unroll
            for (int db = 0; db < 8; ++db) { o1[db] = *(const u32x2*)(gp + ATTW + 16 * db); o2[db] = *(const u32x2*)(gp + 2 * ATTW + 16 * db); }
            l1 = lse[tokrow * 36 + 12 + cur.gh]; l2 = lse[tokrow * 36 + 24 + cur.gh];
            asm volatile("" ::: "memory");
        }
        f32x4 o[8];
#pragma unroll
        for (int db = 0; db < 8; ++db) o[db] = (f32x4){0.f, 0.f, 0.f, 0.f};
#pragma unroll
        for (int kp = 0; kp < 5; ++kp) {
            u32x4 pw; pw.x = cvt_pk_bf16(s[2 * kp][0], s[2 * kp][1]); pw.y = cvt_pk_bf16(s[2 * kp][2], s[2 * kp][3]);
            if (kp < 4) { pw.z = cvt_pk_bf16(s[2 * kp + 1][0], s[2 * kp + 1][1]); pw.w = cvt_pk_bf16(s[2 * kp + 1][2], s[2 * kp + 1][3]); } else { pw.z = 0u; pw.w = 0u; }
            const bf16x8 pb = __builtin_bit_cast(bf16x8, pw);
            const int rowA = (sb + kw0 + 32 * kp + 4 * G + (qi >> 2)) & 255, rowB = (rowA + 16) & 255;
            const LAS unsigned char* pa = Vl + rowA * ATT_VP + (qi & 3) * 8; const LAS unsigned char* pbv = Vl + rowB * ATT_VP + (qi & 3) * 8;
#pragma unroll
            for (int db = 0; db < 8; ++db) {
                const s16x4 t0 = __builtin_bit_cast(s16x4, __builtin_amdgcn_ds_read_tr16_b64_v4i16((LAS s16x4*)(pa + db * 32)));
                const s16x4 t1 = __builtin_bit_cast(s16x4, __builtin_amdgcn_ds_read_tr16_b64_v4i16((LAS s16x4*)(pbv + db * 32)));
                const bf16x8 a = (bf16x8){t0[0], t0[1], t0[2], t0[3], t1[0], t1[1], t1[2], t1[3]};
                o[db] = __builtin_amdgcn_mfma_f32_16x16x32_bf16(a, pb, o[db], 0, 0, 0); }
        }
        const float inv = __builtin_amdgcn_rcpf(lsum);
        if (MODE == 0) {
            bf16* op = og + tokrow * (3 * ATTW) + cur.gh * HD + 4 * G;
#pragma unroll
            for (int db = 0; db < 8; ++db) { u32x2 w; w.x = cvt_pk_bf16(o[db][0] * inv, o[db][1] * inv); w.y = cvt_pk_bf16(o[db][2] * inv, o[db][3] * inv); *(u32x2*)(op + 16 * db) = w; }
            if (G == 0) lse[tokrow * 36 + cur.gh] = m + __builtin_amdgcn_logf(lsum);
        } else {
            const float l0 = m + __builtin_amdgcn_logf(lsum), mx = fmaxf(l0, fmaxf(l1, l2));
            float w0 = __builtin_amdgcn_exp2f(l0 - mx), w1 = __builtin_amdgcn_exp2f(l1 - mx), w2 = __builtin_amdgcn_exp2f(l2 - mx);
            const float wi = __builtin_amdgcn_rcpf(w0 + w1 + w2); w0 *= wi * inv; w1 *= wi; w2 *= wi;
            bf16* mp = mix + tokrow * DM + cur.gh * HD + 4 * G;
#pragma unroll
            for (int db = 0; db < 8; ++db) { u32x2 w;
                w.x = cvt_pk_bf16(w0 * o[db][0] + w1 * bf_lo(o1[db].x) + w2 * bf_lo(o2[db].x), w0 * o[db][1] + w1 * bf_hi(o1[db].x) + w2 * bf_hi(o2[db].x));
                w.y = cvt_pk_bf16(w0 * o[db][2] + w1 * bf_lo(o1[db].y) + w2 * bf_lo(o2[db].y), w0 * o[db][3] + w1 * bf_hi(o1[db].y) + w2 * bf_hi(o2[db].y));
                *(u32x2*)(mp + 16 * db) = w; }
        }
        LDS_BARRIER();
        if (!has_next) break;
        cur = nxt; u = un; st = stn;
    }
}

template <int HW> __device__ __forceinline__ void pool_task(const bf16* __restrict__ z, bf16* __restrict__ mix, const bf16* __restrict__ wpt, const float* __restrict__ pscale, int pg, int tile, int lane) {
    const int qi = lane & 15, Gq = lane >> 4, tt = tile * 16 + qi, spos = tt & (SEQ - 1);
    const int lo = (spos - HW) < 0 ? 0 : spos - HW, hi = (spos + HW + 1) > SEQ ? SEQ : spos + HW + 1; const float rc = 1.0f / (float)(hi - lo);
    const bf16* ub = z + (size_t)(tt - spos) * INW + QKVW + pg * 128 + 8 * Gq;
    bf16x8 df[4];
#pragma unroll
    for (int ks = 0; ks < 4; ++ks) { float acc[8];
#pragma unroll
        for (int k = 0; k < 8; ++k) acc[k] = 0.f;
        u32x4 sv;
#pragma unroll
        for (int w0 = 0; w0 < 2 * HW + 1; w0 += 9) {
            constexpr int NB = 9; u32x4 wv[NB];
#pragma unroll
            for (int w = 0; w < NB; ++w) if (w0 + w < 2 * HW + 1) { int sp = spos - HW + w0 + w; sp = sp < 0 ? 0 : (sp > SEQ - 1 ? SEQ - 1 : sp); wv[w] = *(const u32x4*)(ub + (size_t)sp * INW + 32 * ks); }
#pragma unroll
            for (int w = 0; w < NB; ++w) if (w0 + w < 2 * HW + 1) { const int sp = spos - HW + w0 + w; const float msk = (sp >= 0 && sp < SEQ) ? 1.0f : 0.0f;
                if (w0 + w == HW) sv = wv[w];
#pragma unroll
                for (int k = 0; k < 4; ++k) { acc[2 * k] += msk * bf_lo(wv[w][k]); acc[2 * k + 1] += msk * bf_hi(wv[w][k]); } }
            if (2 * HW + 1 > 9) asm volatile("" ::: "memory");
        }
        u32x4 dw;
#pragma unroll
        for (int k = 0; k < 4; ++k) dw[k] = cvt_pk_bf16(acc[2 * k] * rc - bf_lo(sv[k]), acc[2 * k + 1] * rc - bf_hi(sv[k]));
        df[ks] = __builtin_bit_cast(bf16x8, dw);
        asm volatile("" ::: "memory"); }
    const bf16* wb = wpt + (size_t)pg * 16384 + (size_t)qi * 128 + 8 * Gq;
    bf16* mp = mix + (size_t)tt * DM + ATTW + pg * 128 + 4 * Gq;
#pragma unroll
    for (int eb = 0; eb < 8; ++eb) { f32x4 a4 = (f32x4){0.f, 0.f, 0.f, 0.f};
#pragma unroll
        for (int ks = 0; ks < 4; ++ks) { const bf16x8 wf = *(const bf16x8*)(wb + (size_t)eb * 16 * 128 + 32 * ks); a4 = __builtin_amdgcn_mfma_f32_16x16x32_bf16(wf, df[ks], a4, 0, 0, 0); }
        const f32x4 ps = *(const f32x4*)(pscale + pg * 128 + 16 * eb + 4 * Gq);
        u32x2 w; w.x = cvt_pk_bf16(a4[0] * ps[0], a4[1] * ps[1]); w.y = cvt_pk_bf16(a4[2] * ps[2], a4[3] * ps[3]); *(u32x2*)(mp + 16 * eb) = w; }
}
__device__ __forceinline__ void pool_phase(const bf16* __restrict__ z, bf16* __restrict__ mix, const bf16* __restrict__ wpt  , const float* __restrict__ pscale  , int lane, int wave, int G_) {
    const int gw = blockIdx.x * 8 + wave, NGW = G_ * 8;
    for (int tile = (gw + 0 * (NGW / 4)) % NGW; tile < TC / 16; tile += NGW) pool_task<1>(z, mix, wpt, pscale, 0, tile, lane);
    for (int tile = (gw + 1 * (NGW / 4)) % NGW; tile < TC / 16; tile += NGW) pool_task<2>(z, mix, wpt, pscale, 1, tile, lane);
    for (int tile = (gw + 2 * (NGW / 4)) % NGW; tile < TC / 16; tile += NGW) pool_task<4>(z, mix, wpt, pscale, 2, tile, lane);
    for (int tile = (gw + 3 * (NGW / 4)) % NGW; tile < TC / 16; tile += NGW) pool_task<8>(z, mix, wpt, pscale, 3, tile, lane);
}

__device__ __forceinline__ void final_norm(float* out, const bf16* xbf, const float* ss, const float* fg, int lane, int wave, int G_) {
    const int gw = blockIdx.x * 8 + wave, NGW = G_ * 8;
    f32x4 gv[8];
#pragma unroll
    for (int j = 0; j < 4; ++j) { gv[2 * j] = *(const f32x4*)(fg + 8 * lane + 512 * j); gv[2 * j + 1] = *(const f32x4*)(fg + 8 * lane + 512 * j + 4); }
    for (int row = gw; row < NTOK; row += NGW) { const float rs = __builtin_amdgcn_rsqf(wave_sum(lane < 32 ? ss[(size_t)row * 32 + lane] : 0.f) * pg8::INV_D + pg8::RMS_EPS);
        const bf16* xr = xbf + (size_t)row * DM + 8 * lane; float* orow = out + (size_t)row * DM + 8 * lane;
#pragma unroll
        for (int j = 0; j < 4; ++j) { const u32x4 v = *(const u32x4*)(xr + 512 * j);
            f32x4 a = (f32x4){bf_lo(v[0]), bf_hi(v[0]), bf_lo(v[1]), bf_hi(v[1])}, b = (f32x4){bf_lo(v[2]), bf_hi(v[2]), bf_lo(v[3]), bf_hi(v[3])};
            *(f32x4*)(orow + 512 * j) = a * rs * gv[2 * j]; *(f32x4*)(orow + 512 * j + 4) = b * rs * gv[2 * j + 1]; } }
}

#define SITE_IDS() int tid = (wave0_ << 6) | pg8::lane_id_fresh(); asm volatile("" : "+v"(tid)); const int lane = tid & 63, wave = __builtin_amdgcn_readfirstlane(tid >> 6); (void)lane; (void)wave
struct SkipOrder : pg8::StaticOrder { __device__ bool next(int i, pg8::Unit& u) const { if (!pg8::StaticOrder::next(i, u)) return false; if (u.pn >= 16) u.pn += 2; return true; } };
struct PairOrder : pg8::StaticOrder { __device__ bool next(int i, pg8::Unit& u) const { if (!pg8::StaticOrder::next(i, u)) return false; u.pn += 16; return true; } };
struct HotOrder : pg8::StaticOrder { bool hot;
    __device__ bool next(int i, pg8::Unit& u) const { if (!pg8::StaticOrder::next(i, u)) return false; if (hot) { u.pm = c & 7; u.pn = (c >> 3) & 1; } return true; }
};
struct RangeOrder : pg8::StaticOrder { int lo, hi;
    __device__ bool next(int i, pg8::Unit& u) const { if (lo + i >= hi) return false; return pg8::StaticOrder::next(lo + i, u); }
};
#ifndef DUP_ATT
#define DUP_ATT 1
#endif
#ifndef DUP_ATT1
#define DUP_ATT1 1
#endif
#ifndef DUP_BAR
#define DUP_BAR 1
#endif
#ifndef DUP_MP
#define DUP_MP 1
#endif
#ifndef DUP_GU
#define DUP_GU 1
#endif
#ifndef DUP_IN
#define DUP_IN 1
#endif
#ifndef DUP_DN
#define DUP_DN 1
#endif
#ifndef DUP_OUT
#define DUP_OUT 1
#endif
#ifndef GP_ALIGN
#define GP_ALIGN true
#endif
#ifndef GP_ALIGN8
#define GP_ALIGN8 true
#endif
#ifndef GP_SP28
#define GP_SP28 true
#endif
#ifndef GP_SP2
#define GP_SP2 true
#endif
#ifndef WGM_GU
#define WGM_GU 4
#endif
#ifndef WGM_GU8
#define WGM_GU8 4
#endif
#ifndef WGM_IN8
#define WGM_IN8 6
#endif
#ifndef WGM_N2K
#define WGM_N2K 4
#endif
#ifndef ROT_IN8
#define ROT_IN8 1
#endif
#ifndef PMX_DN
#define PMX_DN 4
#endif
#ifndef PMX_OUT
#define PMX_OUT 0
#endif
#ifndef DUP_PRO
#define DUP_PRO 1
#endif
struct Args { Ptrs p; int lo, hi; };
__global__ void __launch_bounds__(512, 2) fwd(Args args) {
    extern __shared__ __attribute__((aligned(16))) unsigned char lds_raw[];
    LAS unsigned char* lds = (LAS unsigned char*)lds_raw;
    const int G = gridDim.x;
    const Ptrs& P = args.p;
    unsigned char* ws = P.ws;
    volatile LAS unsigned* MISC = (volatile LAS unsigned*)(lds + MISC_OFF);
    if (threadIdx.x < 16) MISC[threadIdx.x] = 0u;
    __syncthreads();
    XcdBarrier bar = xcd_barrier_post((unsigned*)(ws + WS_CTL) + CW_BAR, MISC + 8);
    const int wave0_ = (int)bar.wv;
    const int lo = args.lo, hi = args.hi;
    int step = 0;
#define RUN_STEP (step >= lo && step < hi)
#define END_STEP do { if (step >= lo && step + 1 < hi) { for (int rep_ = 0; rep_ < DUP_BAR; ++rep_) xcd_barrier(bar); } ++step; } while (0)
    float* SS = (float*)(ws + WS_SS);
    bf16* XB = (bf16*)(ws + WS_XB); bf16* HB = (bf16*)(ws + WS_H); bf16* OG = (bf16*)(ws + WS_OG); bf16* ZB = (bf16*)(ws + WS_Z); bf16* MIX = (bf16*)(ws + WS_MIX);
    float* LSE = (float*)(ws + WS_LSE);

    if (RUN_STEP) { SITE_IDS(); for (int rep = 0; rep < DUP_PRO; ++rep) prologue(P, lds, tid, lane, wave, G, 0); }
    END_STEP;

    for (int c = 0; c < NCHUNK; ++c) {
        const size_t r0 = (size_t)c * TC;
        bf16* xb = XB + r0 * DM;
        for (int i = 0; i < 2 * DEPTH; ++i) {
            const int l = i >> 1, j = i & 1;
            const unsigned char* wl = ws + WS_W + (size_t)l * W_LAYER;
            const bool gu8 = ((I8GU_MASK >> i) & 1u) != 0u;
            if (I8GU_MASK != 0u && gu8) {
                if (RUN_STEP) { SITE_IDS(); quant_rows<false>(xb, ws + WS_XB8 + r0 * DM, (float*)(ws + WS_SA) + r0, nullptr, SS + ((size_t)(3 * l + 2 * j) * NTOK + r0) * 32, lane, wave, G); }
                END_STEP;
                if (RUN_STEP) { pg8::Gemm g{(const bf16*)(ws + WS_XB8 + r0 * DM), (const bf16*)(wl + (j ? WO_GU1 : WO_GU0)), TC, NGU, DM}; pg8::StaticOrder S; S.init(TC, NGU, G, (int)blockIdx.x, WGM_GU8);
                    pg8::EpiSwiGLUI8 E{HB, DFF, (const float*)ws, (unsigned)(WS_SA + r0 * 4), (unsigned)(WS_CM + (size_t)(CM_GU + i * NGU) * 4)};
                    for (int rep = 0; rep < DUP_GU8; ++rep) pg8::gemm_phase<pg8::EpiSwiGLUI8, pg8::StaticOrder, GP_ALIGN8, GP_SP28, 3>(lds, g, S, E, wave0_); }
                END_STEP;
            } else {
            if (RUN_STEP) { pg8::Gemm g{xb, (const bf16*)(wl + (j ? WO_GU1 : WO_GU0)), TC, NGU, DM}; pg8::StaticOrder S; S.init(TC, NGU, G, (int)blockIdx.x, WGM_GU);
                pg8::EpiSwiGLU E{HB, DFF, SS + ((size_t)(3 * l + 2 * j) * NTOK + r0) * 32};
#if defined(HOT_GU)
                HotOrder S2; S2.init(TC, NGU, G, (int)blockIdx.x);
                for (int rep = 0; rep < 2; ++rep) { S2.hot = (rep == 0); pg8::EpiSwiGLU E2{rep == 0 ? (bf16*)(ws + WS_END) : HB, DFF, SS + ((size_t)(3 * l + 2 * j) * NTOK + r0) * 32};
                  pg8::gemm_phase<pg8::EpiSwiGLU, HotOrder, GP_ALIGN, GP_SP2>(lds, g, S2, E2, wave0_); }
#else
#if defined(PROBE_SPLIT)
                { RangeOrder S3; S3.init(TC, NGU, G, (int)blockIdx.x, WGM_GU); S3.lo = 0; S3.hi = 5; pg8::gemm_phase<pg8::EpiSwiGLU, RangeOrder, GP_ALIGN, GP_SP2>(lds, g, S3, E, wave0_);
                  xcd_barrier(bar);
                  S3.lo = 5; S3.hi = 11; pg8::gemm_phase<pg8::EpiSwiGLU, RangeOrder, GP_ALIGN, GP_SP2>(lds, g, S3, E, wave0_); }
#else
                for (int rep = 0; rep < DUP_GU; ++rep) pg8::gemm_phase<pg8::EpiSwiGLU, pg8::StaticOrder, GP_ALIGN, GP_SP2>(lds, g, S, E, wave0_);
#endif
#endif
                }
            END_STEP;
            }
            if (RUN_STEP) { pg8::Gemm g{HB, (const bf16*)(wl + (j ? WO_D1 : WO_D0)), TC, DM, DFF}; pg8::StaticOrder S; S.init(TC, DM, G, (int)blockIdx.x, WGM_N2K, 1, PMX_DN);
                pg8::EpiResidual E{xb, SS + ((size_t)(3 * l + 2 * j + 1) * NTOK + r0) * 32, 0.5f, nullptr, xb};
#if defined(PROBE_DN)
                for (int rep = 0; rep < 2; ++rep) { pg8::EpiResidual E2 = E; if (rep == 0) { E2.xw = (bf16*)(ws + WS_END); E2.ssn = SS + (size_t)13 * NTOK * 32; E2.x8 = nullptr; } pg8::gemm_phase<pg8::EpiResidual, pg8::StaticOrder, GP_ALIGN, GP_SP2>(lds, g, S, E2, wave0_); }
#else
                pg8::gemm_phase<pg8::EpiResidual, pg8::StaticOrder, false, GP_SP2>(lds, g, S, E, wave0_);
#endif
                }
            END_STEP;
            if (j == 0) {
                if (RUN_STEP) { SITE_IDS(); quant_rows<true>(xb, ws + WS_XB8 + r0 * DM, (float*)(ws + WS_SA) + r0, (float*)(ws + WS_SR) + r0, SS + ((size_t)(3 * l + 1) * NTOK + r0) * 32, lane, wave, G); }
                END_STEP;
                if (RUN_STEP) {
                    { constexpr int NIN8 = I8_POOLIN ? INW : QKVW;
                      pg8::Gemm g{(const bf16*)(ws + WS_XB8 + r0 * DM), (const bf16*)(wl + WO_IN), TC, NIN8, DM}; SkipOrder S; S.init(TC, NIN8 - 512, G, (int)blockIdx.x, WGM_IN8, ROT_IN8);
                      pg8::EpiScaleI8 E{ZB, INW, (const float*)ws, (unsigned)(WS_SA + r0 * 4), (unsigned)(WS_CM + (size_t)(CM_IN + l * INW) * 4), QSCALE, 1.0f};
                      for (int rep = 0; rep < DUP_IN8; ++rep) pg8::gemm_phase<pg8::EpiScaleI8, SkipOrder, GP_ALIGN8, GP_SP28, 3>(lds, g, S, E, wave0_); }
                    }
                END_STEP;
                if (RUN_STEP) {
                    { pg8::Gemm g{(const bf16*)(ws + WS_XB8 + r0 * DM), (const bf16*)(wl + WO_IN), TC, QKVW, DM}; PairOrder S; S.init(TC, 512, G, (int)blockIdx.x, 4, 0);
                      pg8::EpiScaleI8 E{ZB, INW, (const float*)ws, (unsigned)(WS_SA + r0 * 4), (unsigned)(WS_CM + (size_t)(CM_IN + l * INW) * 4), QSCALE, 1.0f};
                      pg8::gemm_phase<pg8::EpiScaleI8, PairOrder, GP_ALIGN8, GP_SP28, 3>(lds, g, S, E, wave0_); }
                    if (!I8_POOLIN) { pg8::Gemm g{xb, (const bf16*)(wl + WO_INU), TC, POOLW, DM}; pg8::StaticOrder S; S.init(TC, POOLW, G, ((int)blockIdx.x + G / 2) % G);
                      pg8::EpiScaleBf16 E{ZB + QKVW, INW, (const float*)(ws + WS_SR) + r0, 1.0f, 1.0f, 0};
                      pg8::gemm_phase<pg8::EpiScaleBf16, pg8::StaticOrder, GP_ALIGN, GP_SP2, 2>(lds, g, S, E, wave0_); }
                    SITE_IDS(); const int n0 = G - G / 2, n1 = G / 2, bx = (int)blockIdx.x; const bool up = bx >= n0;
                    const int ci = (G % 16 == 0) ? (bx % 8) * (G / 16) + (bx / 8) % (G / 16) : (up ? bx - n0 : bx);
                    for (int rep = 0; rep < DUP_ATT; ++rep) attn_phase<0>(ZB, OG, LSE, MIX, (const float*)(ws + WS_LUT), lds, tid, lane, wave, up ? ATT_SPLIT + ci : ci, up ? n1 : n0, up ? 2304 : ATT_SPLIT); }
                END_STEP;
                if (RUN_STEP) { SITE_IDS(); const int vcu = (G % 8 == 0) ? ((int)blockIdx.x % 8) * (G / 8) + (int)blockIdx.x / 8 : (int)blockIdx.x;
                    for (int rep = 0; rep < DUP_ATT1; ++rep) attn_phase<1>(ZB, OG, LSE, MIX, (const float*)(ws + WS_LUT), lds, tid, lane, wave, vcu, G, 768); }
                if (RUN_STEP) { SITE_IDS();
                    for (int rep = 0; rep < DUP_MP; ++rep) pool_phase(ZB, MIX, (const bf16*)(ws + WS_WPT) + (size_t)l * 4 * 16384, P.pool_scale + l * POOLW, lane, wave, G); }
                END_STEP;
                if (RUN_STEP) { pg8::Gemm g{MIX, (const bf16*)(wl + WO_OUT), TC, DM, DM}; pg8::StaticOrder S; S.init(TC, DM, G, (int)blockIdx.x, WGM_N2K, 1, PMX_OUT);
                    pg8::EpiResidual E{xb, SS + ((size_t)(3 * l + 2) * NTOK + r0) * 32, 1.0f, nullptr, xb};
#if defined(PROBE_OUT)
                    for (int rep = 0; rep < 2; ++rep) { pg8::EpiResidual E2 = E; if (rep == 0) { E2.xw = (bf16*)(ws + WS_END); E2.ssn = SS + (size_t)13 * NTOK * 32; } pg8::gemm_phase<pg8::EpiResidual, pg8::StaticOrder, GP_ALIGN, GP_SP2>(lds, g, S, E2, wave0_); }
#else
                    pg8::gemm_phase<pg8::EpiResidual, pg8::StaticOrder, false, GP_SP2>(lds, g, S, E, wave0_);
#endif
                    }
                END_STEP;
            }
        }
    }
    if (RUN_STEP) { SITE_IDS(); final_norm(P.out, XB, SS + (size_t)12 * NTOK * 32, P.final_g, lane, wave, G); }
    END_STEP;
#undef RUN_STEP
#undef END_STEP
}

#ifndef MK_MULTI
#define MK_MULTI 0
#endif
extern "C" void kernel_launch(void* const* d_in, const int* in_sizes, int n_in, void* d_out, int out_size, void* d_ws, size_t ws_size, hipStream_t stream) {
    static int grid = 0;
    if (grid == 0) {
        if (n_in != 12 || out_size != NTOK * DM || ws_size < WS_END) { fprintf(stderr, "kernel_launch: unexpected problem (n_in %d, out %d, ws %zu)\n", n_in, out_size, ws_size); grid = -1; return; }
        int dev = 0, cus = 0, per_cu = 0;
        if (hipGetDevice(&dev) != hipSuccess || hipDeviceGetAttribute(&cus, hipDeviceAttributeMultiprocessorCount, dev) != hipSuccess) { grid = -1; return; }
        if (hipFuncSetAttribute((const void*)fwd, hipFuncAttributeMaxDynamicSharedMemorySize, LDS_BYTES) != hipSuccess) { fprintf(stderr, "kernel_launch: hipFuncSetAttribute failed\n"); grid = -1; return; }
        if (hipOccupancyMaxActiveBlocksPerMultiprocessor(&per_cu, (const void*)fwd, 512, LDS_BYTES) != hipSuccess || per_cu < 1) { fprintf(stderr, "kernel_launch: occupancy query says %d\n", per_cu); }
        (void)hipGetLastError();
        grid = cus;
    }
    if (grid < 0) return;
    (void)hipMemsetAsync((char*)d_ws + WS_CTL, 0, CTL_ZERO_BYTES, stream);
    Args a{};
    a.p.x_prompt = (const float*)d_in[0]; a.p.x_sample = (const float*)d_in[1]; a.p.norm_g = (const float*)d_in[2]; a.p.ffn_gate = (const float*)d_in[3];
    a.p.ffn_up = (const float*)d_in[4]; a.p.ffn_down = (const float*)d_in[5]; a.p.w_in = (const float*)d_in[6]; a.p.w_pool = (const float*)d_in[7];
    a.p.pool_scale = (const float*)d_in[8]; a.p.w_out = (const float*)d_in[9]; a.p.rel_bias = (const float*)d_in[10]; a.p.final_g = (const float*)d_in[11];
    a.p.out = (float*)d_out; a.p.ws = (unsigned char*)d_ws;
#if MK_MULTI
    for (int s = 0; s < NSTEPS; ++s) { a.lo = s; a.hi = s + 1; hipLaunchKernelGGL(fwd, dim3(grid), dim3(512), LDS_BYTES, stream, a); }
#else
    a.lo = 0; a.hi = 1 << 30;
    hipLaunchKernelGGL(fwd, dim3(grid), dim3(512), LDS_BYTES, stream, a);
#endif
}
```

```cpp
#include <hip/hip_runtime.h>
#include <cstdio>
#include <cstdint>
namespace pg8 {
#define PG8_LAS __attribute__((address_space(3)))
typedef unsigned short bf16_t;
typedef short bf16x8 __attribute__((ext_vector_type(8)));
typedef float f32x4 __attribute__((ext_vector_type(4)));
typedef unsigned u32x4 __attribute__((ext_vector_type(4)));
typedef int i32x8 __attribute__((ext_vector_type(8)));
typedef int i32x4_ __attribute__((ext_vector_type(4)));
constexpr int BM = 256, BK = 64, HALF = 128, HTB = HALF * BK * 2  , STAGE_BYTES = 8 * HTB, NXCD = 8;

__host__ __device__ __forceinline__ int lds_byte(int r, int c) { const int st = (r >> 4) * 2 + (c >> 5), rr = r & 15, cc = c & 31, ob = rr * 64 + cc * 2; return st * 1024 + (ob ^ (((ob >> 9) & 1) << 5)); }
__host__ __device__ __forceinline__ void stage_rc(int b, int& R, int& C) { const int st = b / 1024, sb = b % 1024, swz = sb ^ (((sb >> 9) & 1) << 5); R = (st >> 1) * 16 + swz / 64; C = (st & 1) * 32 + (swz % 64) / 2; }
__host__ __device__ __forceinline__ int perm32(int rho) { const int n = rho >> 4, i = rho & 15; return 8 * (i >> 2) + 4 * n + (i & 3); }

#ifndef PG8_B_BLOCKED
#define PG8_B_BLOCKED 1
#endif
__host__ __device__ __forceinline__ int inv_perm32(int w) { return 16 * ((w >> 2) & 1) + (((w >> 3) << 2) | (w & 3)); }
__host__ __device__ __forceinline__ size_t bblk_off(int n, int kbyte, int Kb) {
    const int slot = (n & ~31) + inv_perm32(n & 31), ob = (slot & 15) * 64 + (kbyte & 63);
    return ((size_t)(slot >> 4) * (size_t)(Kb >> 6) + (size_t)(kbyte >> 6)) * 1024 + (size_t)(ob ^ (((ob >> 9) & 1) << 5)); }
__device__ __forceinline__ int lane_id_fresh() { int l_; asm volatile("v_mbcnt_lo_u32_b32 %0, -1, 0\n\tv_mbcnt_hi_u32_b32 %0, -1, %0" : "=v"(l_)); return l_; }
struct Unit { int pm, pn; };
struct Gemm { const bf16_t* A; const bf16_t* Bt; int M, N, K; };

struct StaticOrder {
    int nM, nN, nwg, G, c, WGM, rot, pmx;
    __host__ __device__ void init(int M, int N, int G_, int c_, int wgm = 4, int rot_ = 1, int pmx_ = 0) { nM = M / BM; nN = N / BM; nwg = nM * nN; G = G_; c = c_; WGM = wgm; rot = rot_; pmx = pmx_; }
    __host__ __device__ bool next(int i, Unit& u) const {
        const long L = (long)i * G + c; if (L >= nwg) return false;
        int wgid = (int)L; { const int q = nwg / NXCD, r = nwg % NXCD, xcd = wgid % NXCD, off = wgid / NXCD; wgid = (xcd < r ? xcd * (q + 1) : r * (q + 1) + (xcd - r) * q) + off; }
        const int nig = WGM * nN, gid = wgid / nig, fm = gid * WGM, gsz = (nM - fm) < WGM ? (nM - fm) : WGM;
        u.pm = fm + ((wgid % nig) % gsz); u.pn = (wgid % nig) / gsz;
        if (rot) u.pn = (u.pn + (u.pm >> 3) * (nN / NXCD)) % nN;
        u.pm ^= pmx; return true;
    }
    __device__ __forceinline__ void a_ready(const Unit&) const {}
    __device__ __forceinline__ void done(const Unit&) const {}
};
__device__ __forceinline__ unsigned cvt_pk_bf16(float lo, float hi) { unsigned r; asm volatile("v_cvt_pk_bf16_f32 %0, %1, %2" : "=v"(r) : "v"(lo), "v"(hi)); return r; }
typedef float f32x2 __attribute__((ext_vector_type(2)));
typedef unsigned u32x2_ __attribute__((ext_vector_type(2)));
constexpr float RMS_EPS = 1e-6f;
constexpr float INV_D = 1.0f / 2048.0f;
__device__ __forceinline__ float row_rstd(const float* ssp, int row, int fq) {
    const f32x4 a = *(const f32x4*)(ssp + (size_t)row * 32 + 8 * fq), b = *(const f32x4*)(ssp + (size_t)row * 32 + 8 * fq + 4);
    float s = ((a[0] + a[1]) + (a[2] + a[3])) + ((b[0] + b[1]) + (b[2] + b[3]));
    s += __shfl_xor(s, 16); s += __shfl_xor(s, 32);
    return __builtin_amdgcn_rsqf(s * INV_D + RMS_EPS);
}
__device__ __forceinline__ float row_msq(const float* ssp, int row, int fq) {
    const f32x4 a = *(const f32x4*)(ssp + (size_t)row * 32 + 8 * fq), b = *(const f32x4*)(ssp + (size_t)row * 32 + 8 * fq + 4);
    float s = ((a[0] + a[1]) + (a[2] + a[3])) + ((b[0] + b[1]) + (b[2] + b[3]));
    s += __shfl_xor(s, 16); s += __shfl_xor(s, 32);
    return s * INV_D + RMS_EPS;
}
struct EpiSwiGLU {
    static constexpr bool PERM = true, AFTER_DRAIN = false, LDS_SCALES = false;
    bf16_t* H; int ldh; const float* ss;
    __device__ __forceinline__ void operator()(const f32x4 (&acc)[2][2][4][2], const Unit& u, int wr, int wc, int fr, int fq) const {
        const int row0 = u.pm * BM + wr * 64 + fr, col0 = u.pn * HALF + wc * 32 + 8 * fq;
#ifdef DUP_EPI
        for (int rep_ = 0; rep_ < DUP_EPI; ++rep_)
#endif
#pragma unroll
        for (int ai = 0; ai < 2; ++ai)
#pragma unroll
            for (int m = 0; m < 4; ++m) { const int row = row0 + ai * HALF + m * 16; const float v = row_msq(ss, row, fq), c1 = -1.4426950408889634f * __builtin_amdgcn_rsqf(v);
                const f32x2 vv = (f32x2){v, v}, cc = (f32x2){c1, c1};
                unsigned w[4]; f32x2 g[4], up[4], e[4], r[4];
#pragma unroll
                for (int q = 0; q < 4; ++q) { g[q] = (f32x2){acc[ai][0][m][q >> 1][2 * (q & 1)], acc[ai][0][m][q >> 1][2 * (q & 1) + 1]}; up[q] = (f32x2){acc[ai][1][m][q >> 1][2 * (q & 1)], acc[ai][1][m][q >> 1][2 * (q & 1) + 1]}; }
#pragma unroll
                for (int q = 0; q < 4; ++q) { const f32x2 ea = g[q] * cc; e[q].x = __builtin_amdgcn_exp2f(ea.x); e[q].y = __builtin_amdgcn_exp2f(ea.y); }
#pragma unroll
                for (int q = 0; q < 4; ++q) { const f32x2 den = e[q] * vv + vv; r[q].x = __builtin_amdgcn_rcpf(den.x); r[q].y = __builtin_amdgcn_rcpf(den.y); }
#pragma unroll
                for (int q = 0; q < 4; ++q) { const f32x2 hv = (g[q] * up[q]) * r[q]; w[q] = cvt_pk_bf16(hv.x, hv.y); }
                u32x4 o; o.x = w[0]; o.y = w[1]; o.z = w[2]; o.w = w[3];
                *(u32x4*)(H + (size_t)row * ldh + col0) = o; }
    }
};
struct EpiScaleBf16 {
    static constexpr bool PERM = true, AFTER_DRAIN = false, LDS_SCALES = false;
    bf16_t* Z; int ldz; const float* rsd; float csq, cso; int qtiles;
    __device__ __forceinline__ void operator()(const f32x4 (&acc)[2][2][4][2], const Unit& u, int wr, int wc, int fr, int fq) const {
        const int row0 = u.pm * BM + wr * 64 + fr, col0 = u.pn * BM + wc * 32 + 8 * fq;
        const float cs = (qtiles && (u.pn % 18) < 6) ? csq : cso;
#pragma unroll
        for (int ai = 0; ai < 2; ++ai)
#pragma unroll
            for (int m = 0; m < 4; ++m) { const int row = row0 + ai * HALF + m * 16; const float rs = rsd[row] * cs;
#pragma unroll
                for (int bj = 0; bj < 2; ++bj) { const f32x4 v0 = acc[ai][bj][m][0] * rs, v1 = acc[ai][bj][m][1] * rs;
                    u32x4 o; o.x = cvt_pk_bf16(v0[0], v0[1]); o.y = cvt_pk_bf16(v0[2], v0[3]); o.z = cvt_pk_bf16(v1[0], v1[1]); o.w = cvt_pk_bf16(v1[2], v1[3]);
                    *(u32x4*)(Z + (size_t)row * ldz + col0 + bj * HALF) = o; } }
    }
};
__device__ __forceinline__ f32x4 i2f4(f32x4 a) { const i32x4_ i = __builtin_bit_cast(i32x4_, a); return (f32x4){(float)i[0], (float)i[1], (float)i[2], (float)i[3]}; }
struct EpiScaleI8 {
    static constexpr bool PERM = true, AFTER_DRAIN = false, LDS_SCALES = true;
    bf16_t* Z; int ldz; const float* sbase; unsigned row_off, col_off; float csq, cso;
    __device__ __forceinline__ void operator()(const f32x4 (&acc)[2][2][4][2], const Unit& u, int wr, int wc, int fr, int fq, const PG8_LAS float* lsc) const {
        const int row0 = u.pm * BM + wr * 64 + fr, col0 = u.pn * BM + wc * 32 + 8 * fq;
        const float cs = ((u.pn < 54 && (u.pn % 18) < 6) ? csq : cso) * (1.0f / 127.0f);
        f32x4 cb[2][2];
#pragma unroll
        for (int bj = 0; bj < 2; ++bj)
#pragma unroll
            for (int n = 0; n < 2; ++n) cb[bj][n] = *(const PG8_LAS f32x4*)(lsc + 256 + wc * 32 + 8 * fq + bj * HALF + 4 * n) * cs;
#pragma unroll
        for (int ai = 0; ai < 2; ++ai)
#pragma unroll
            for (int m = 0; m < 4; ++m) { const int row = row0 + ai * HALF + m * 16; const float rs = lsc[ai * HALF + wr * 64 + m * 16 + fr];
#pragma unroll
                for (int bj = 0; bj < 2; ++bj) { const f32x4 v0 = i2f4(acc[ai][bj][m][0]) * cb[bj][0] * rs, v1 = i2f4(acc[ai][bj][m][1]) * cb[bj][1] * rs;
                    u32x4 o; o.x = cvt_pk_bf16(v0[0], v0[1]); o.y = cvt_pk_bf16(v0[2], v0[3]); o.z = cvt_pk_bf16(v1[0], v1[1]); o.w = cvt_pk_bf16(v1[2], v1[3]);
                    *(u32x4*)(Z + (size_t)row * ldz + col0 + bj * HALF) = o; } }
    }
};
struct EpiSwiGLUI8 {
    static constexpr bool PERM = true, AFTER_DRAIN = false, LDS_SCALES = true;
    bf16_t* H; int ldh; const float* sbase; unsigned row_off, col_off;
    __device__ __forceinline__ void operator()(const f32x4 (&acc)[2][2][4][2], const Unit& u, int wr, int wc, int fr, int fq, const PG8_LAS float* lsc) const {
        const int row0 = u.pm * BM + wr * 64 + fr, col0 = u.pn * HALF + wc * 32 + 8 * fq;
        f32x2 cg[4], cu[4];
        { const PG8_LAS float* lc = lsc + 256 + wc * 32 + 8 * fq;
          const f32x4 g0 = *(const PG8_LAS f32x4*)(lc), g1 = *(const PG8_LAS f32x4*)(lc + 4), u0 = *(const PG8_LAS f32x4*)(lc + HALF), u1 = *(const PG8_LAS f32x4*)(lc + HALF + 4);
          cg[0] = (f32x2){g0[0], g0[1]} * (1.0f / 127.0f); cg[1] = (f32x2){g0[2], g0[3]} * (1.0f / 127.0f); cg[2] = (f32x2){g1[0], g1[1]} * (1.0f / 127.0f); cg[3] = (f32x2){g1[2], g1[3]} * (1.0f / 127.0f);
          cu[0] = (f32x2){u0[0], u0[1]} * (1.0f / 127.0f); cu[1] = (f32x2){u0[2], u0[3]} * (1.0f / 127.0f); cu[2] = (f32x2){u1[0], u1[1]} * (1.0f / 127.0f); cu[3] = (f32x2){u1[2], u1[3]} * (1.0f / 127.0f); }
#pragma unroll
        for (int ai = 0; ai < 2; ++ai)
#pragma unroll
            for (int m = 0; m < 4; ++m) { const int row = row0 + ai * HALF + m * 16; const float a = lsc[ai * HALF + wr * 64 + m * 16 + fr];
                const f32x2 aa = (f32x2){a, a}, ae = (f32x2){a * -1.4426950408889634f, a * -1.4426950408889634f};
                unsigned w[4]; f32x2 gf[4], uf[4], G[4], e[4], r[4];
#pragma unroll
                for (int q = 0; q < 4; ++q) { const i32x4_ gi = __builtin_bit_cast(i32x4_, acc[ai][0][m][q >> 1]), ui = __builtin_bit_cast(i32x4_, acc[ai][1][m][q >> 1]);
                    gf[q] = (f32x2){(float)gi[2 * (q & 1)], (float)gi[2 * (q & 1) + 1]} * cg[q]; uf[q] = (f32x2){(float)ui[2 * (q & 1)], (float)ui[2 * (q & 1) + 1]} * cu[q]; }
#pragma unroll
                for (int q = 0; q < 4; ++q) { const f32x2 ea = gf[q] * ae; e[q].x = __builtin_amdgcn_exp2f(ea.x); e[q].y = __builtin_amdgcn_exp2f(ea.y); G[q] = gf[q] * aa; }
#pragma unroll
                for (int q = 0; q < 4; ++q) { const f32x2 den = e[q] + 1.0f; r[q].x = __builtin_amdgcn_rcpf(den.x); r[q].y = __builtin_amdgcn_rcpf(den.y); }
#pragma unroll
                for (int q = 0; q < 4; ++q) { const f32x2 hv = (G[q] * (uf[q] * aa)) * r[q]; w[q] = cvt_pk_bf16(hv.x, hv.y); }
                u32x4 o; o.x = w[0]; o.y = w[1]; o.z = w[2]; o.w = w[3];
                *(u32x4*)(H + (size_t)row * ldh + col0) = o; }
    }
};
struct EpiResidual {
    static constexpr bool PERM = true, AFTER_DRAIN = false, LDS_SCALES = false;
    bf16_t* xb; float* ssn; float sc; unsigned char* x8; bf16_t* xw;
    __device__ __forceinline__ void operator()(const f32x4 (&acc)[2][2][4][2], const Unit& u, int wr, int wc, int fr, int fq) const {
        const int row0 = u.pm * BM + wr * 64 + fr, col0 = u.pn * BM + wc * 32 + 8 * fq;
        u32x4 xa[2][4][2];
#pragma unroll
        for (int ai = 0; ai < 2; ++ai)
#pragma unroll
            for (int m = 0; m < 4; ++m) { const size_t off = (size_t)(row0 + ai * HALF + m * 16) * 2048 + col0;
#pragma unroll
                for (int bj = 0; bj < 2; ++bj) xa[ai][m][bj] = *(const u32x4*)(xb + off + bj * HALF); }
        asm volatile("" ::: "memory");
#pragma unroll
        for (int ai = 0; ai < 2; ++ai) {
#pragma unroll
            for (int m = 0; m < 4; ++m) { const int row = row0 + ai * HALF + m * 16; const size_t off = (size_t)row * 2048 + col0; float q = 0.f;
#pragma unroll
                for (int bj = 0; bj < 2; ++bj) { const u32x4 xo = xa[ai][m][bj]; const f32x4 d0 = acc[ai][bj][m][0] * sc, d1 = acc[ai][bj][m][1] * sc;
                    const float a0 = __uint_as_float(xo[0] << 16) + d0[0], a1 = __uint_as_float(xo[0] & 0xffff0000u) + d0[1], a2 = __uint_as_float(xo[1] << 16) + d0[2], a3 = __uint_as_float(xo[1] & 0xffff0000u) + d0[3];
                    const float b0 = __uint_as_float(xo[2] << 16) + d1[0], b1 = __uint_as_float(xo[2] & 0xffff0000u) + d1[1], b2 = __uint_as_float(xo[3] << 16) + d1[2], b3 = __uint_as_float(xo[3] & 0xffff0000u) + d1[3];
                    u32x4 o; o.x = cvt_pk_bf16(a0, a1); o.y = cvt_pk_bf16(a2, a3); o.z = cvt_pk_bf16(b0, b1); o.w = cvt_pk_bf16(b2, b3);
                    *(u32x4*)(xw + off + bj * HALF) = o;
                    if (x8) { u32x2_ e; e.x = __builtin_amdgcn_cvt_pk_fp8_f32(a0, a1, 0, false); e.x = __builtin_amdgcn_cvt_pk_fp8_f32(a2, a3, e.x, true);
                        e.y = __builtin_amdgcn_cvt_pk_fp8_f32(b0, b1, 0, false); e.y = __builtin_amdgcn_cvt_pk_fp8_f32(b2, b3, e.y, true); *(u32x2_*)(x8 + off + bj * HALF) = e; }
                    q += (a0 * a0 + a1 * a1) + (a2 * a2 + a3 * a3) + (b0 * b0 + b1 * b1) + (b2 * b2 + b3 * b3); }
                q += __shfl_xor(q, 16); q += __shfl_xor(q, 32);
                if (fq == 0) ssn[(size_t)row * 32 + u.pn * 4 + wc] = q; }
            asm volatile("" ::: "memory"); }
    }
};
template <class Epi, class Sched, bool ALIGN_EPI = false, bool SP2 = false, int ESZ = 2>
__device__ __forceinline__ void gemm_phase(PG8_LAS unsigned char* lds, const Gemm g, const Sched& S, const Epi& E, int wv  ) {
    constexpr bool B_BLOCKED = (PG8_B_BLOCKED != 0) && Epi::PERM;
    int tid_ = (wv << 6) | lane_id_fresh(); asm volatile("" : "+v"(tid_));
    const int tid = tid_, wid = __builtin_amdgcn_readfirstlane(tid >> 6), lane = tid & 63, wr = wid >> 2, wc = wid & 3, fr = lane & 15, fq = lane >> 4;
    const int K = g.K, Kb = K * (ESZ == 2 ? 2 : 1)  , nt = Kb / (BK * 2);
    unsigned voffA[2], voffB[2];
#pragma unroll
    for (int i = 0; i < 2; ++i) { int R, C; stage_rc(tid * 16 + i * 8192, R, C); const int Rb = Epi::PERM ? ((R & ~31) + perm32(R & 31)) : R;
        voffA[i] = (unsigned)(R * Kb + C * 2);
        if constexpr (B_BLOCKED) { const int b_ = tid * 16 + i * 8192, st_ = b_ >> 10; (void)Rb; voffB[i] = (unsigned)(((st_ >> 1) * (Kb >> 6) + (st_ & 1)) * 1024 + (b_ & 1023)); }
        else voffB[i] = (unsigned)(Rb * Kb + C * 2); }
    const unsigned kstep = (unsigned)(BK * 2);
    const unsigned kstepB = B_BLOCKED ? 2048u : kstep;
    const unsigned hstep = (unsigned)HALF * (unsigned)Kb;
    const unsigned tstep = 2u * hstep;
    const unsigned ldsw = (unsigned)wid * 1024u;
    const int aoff = lds_byte(wr * 64 + fr, fq * 8), boff = lds_byte(wc * 32 + fr, fq * 8);
#define PG8_SA(b, h) (((b) * 2 + (h)) * HTB)
#define PG8_SB(b, h) ((4 + (b) * 2 + (h)) * HTB)
#define PG8_STAGE(bufoff, rsrc, soff, voff) do { _Pragma("unroll") for (int _i = 0; _i < 2; ++_i) \
        __builtin_amdgcn_raw_ptr_buffer_load_lds((rsrc), (PG8_LAS void*)(lds + (bufoff) + ldsw + _i * 8192), 16, (int)(voff)[_i], (int)(soff), 0, 0); } while (0)
#define PG8_LDA(dst, b, h) do { _Pragma("unroll") for (int m = 0; m < 4; ++m) _Pragma("unroll") for (int k = 0; k < 2; ++k) dst[m][k] = *(const PG8_LAS bf16x8*)(lds + PG8_SA(b, h) + aoff + m * 2048 + k * 1024); } while (0)
#define PG8_LDB(dst, b, h) do { _Pragma("unroll") for (int n = 0; n < 2; ++n) _Pragma("unroll") for (int k = 0; k < 2; ++k) dst[n][k] = *(const PG8_LAS bf16x8*)(lds + PG8_SB(b, h) + boff + n * 2048 + k * 1024); } while (0)
#define PG8_MMA(ai, bj, At, Bt) do { __builtin_amdgcn_s_setprio(1); \
        if constexpr (ESZ == 2) { _Pragma("unroll") for (int m = 0; m < 4; ++m) _Pragma("unroll") for (int n = 0; n < 2; ++n) _Pragma("unroll") for (int k = 0; k < 2; ++k) \
            acc[ai][bj][m][n] = __builtin_amdgcn_mfma_f32_16x16x32_bf16(Bt[n][k], At[m][k], acc[ai][bj][m][n], 0, 0, 0); } \
        else if constexpr (ESZ == 3) { _Pragma("unroll") for (int m = 0; m < 4; ++m) _Pragma("unroll") for (int n = 0; n < 2; ++n) _Pragma("unroll") for (int k = 0; k < 2; ++k) \
            acc[ai][bj][m][n] = __builtin_bit_cast(f32x4, __builtin_amdgcn_mfma_i32_16x16x64_i8(__builtin_bit_cast(i32x4_, Bt[n][k]), __builtin_bit_cast(i32x4_, At[m][k]), __builtin_bit_cast(i32x4_, acc[ai][bj][m][n]), 0, 0, 0)); } \
        else { _Pragma("unroll") for (int m = 0; m < 4; ++m) _Pragma("unroll") for (int n = 0; n < 2; ++n) { \
            const i32x8 b8_ = __builtin_shufflevector(__builtin_bit_cast(i32x4_, Bt[n][0]), __builtin_bit_cast(i32x4_, Bt[n][1]), 0, 1, 2, 3, 4, 5, 6, 7); \
            const i32x8 a8_ = __builtin_shufflevector(__builtin_bit_cast(i32x4_, At[m][0]), __builtin_bit_cast(i32x4_, At[m][1]), 0, 1, 2, 3, 4, 5, 6, 7); \
            asm volatile("v_mfma_scale_f32_16x16x128_f8f6f4 %0, %1, %2, %0, %3, %3 op_sel_hi:[0,0,0]" : "+v"(acc[ai][bj][m][n]) : "v"(b8_), "v"(a8_), "v"(one8_)); } } \
        __builtin_amdgcn_s_setprio(0); } while (0)
#define PG8_WAIT_V(n) asm volatile("s_waitcnt vmcnt(" #n ")" ::: "memory")
#define PG8_WAIT_L(n) asm volatile("s_waitcnt lgkmcnt(" #n ")" ::: "memory")
#define PG8_BAR __builtin_amdgcn_s_barrier()
#define PG8_SCHED __builtin_amdgcn_sched_barrier(0)
    const int one8_ = 0x7f7f7f7f;
    Unit cur, nxt; int ui = 0;
    if (!S.next(0, cur)) return;
    f32x4 acc[2][2][4][2];
#pragma unroll
    for (int a = 0; a < 2; ++a)
#pragma unroll
        for (int b = 0; b < 2; ++b)
#pragma unroll
            for (int m = 0; m < 4; ++m)
#pragma unroll
                for (int n = 0; n < 2; ++n) { typedef double f64x2_ __attribute__((ext_vector_type(2))); f64x2_ z_; asm volatile("v_mov_b64 %0, 0" : "=v"(z_.x)); asm volatile("v_mov_b64 %0, 0" : "=v"(z_.y)); acc[a][b][m][n] = __builtin_bit_cast(f32x4, z_); }
    bf16x8 At[4][2], B0[2][2], B1[2][2];
    const __amdgpu_buffer_rsrc_t rA = __builtin_amdgcn_make_buffer_rsrc((void*)g.A, 0, (int)((unsigned)g.M * (unsigned)Kb), 0x00020000), rB = __builtin_amdgcn_make_buffer_rsrc((void*)g.Bt, 0, (int)((unsigned)g.N * (unsigned)Kb), 0x00020000);
    unsigned cA = (unsigned)cur.pm * tstep, cB = (unsigned)cur.pn * tstep;
    __amdgpu_buffer_rsrc_t rS = rA; unsigned voffS = 0;
    if constexpr (Epi::LDS_SCALES) { rS = __builtin_amdgcn_make_buffer_rsrc((void*)E.sbase, 0, 1 << 24, 0x00020000); voffS = (unsigned)(lane * 4 + (wid & 3) * 256); }
    S.a_ready(cur);
    if constexpr (SP2) {
        PG8_STAGE(PG8_SB(0, 0), rB, cB, voffB); PG8_STAGE(PG8_SB(0, 1), rB, cB + hstep, voffB); PG8_STAGE(PG8_SA(0, 0), rA, cA, voffA); PG8_STAGE(PG8_SA(0, 1), rA, cA + hstep, voffA);
        if (wr == 1) PG8_BAR;
        PG8_WAIT_V(2); PG8_BAR;
        PG8_STAGE(PG8_SB(1, 0), rB, cB + kstepB, voffB); PG8_STAGE(PG8_SA(1, 0), rA, cA + kstep, voffA); PG8_STAGE(PG8_SB(1, 1), rB, cB + hstep + kstepB, voffB);
        PG8_WAIT_V(6); PG8_BAR;
    } else {
        PG8_STAGE(PG8_SB(0, 0), rB, cB, voffB); PG8_STAGE(PG8_SA(0, 0), rA, cA, voffA); PG8_STAGE(PG8_SB(0, 1), rB, cB + hstep, voffB); PG8_STAGE(PG8_SA(0, 1), rA, cA + hstep, voffA);
        if (wr == 1) PG8_BAR;
        PG8_WAIT_V(4); PG8_BAR;
        PG8_STAGE(PG8_SB(1, 0), rB, cB + kstepB, voffB); PG8_STAGE(PG8_SA(1, 0), rA, cA + kstep, voffA); PG8_STAGE(PG8_SB(1, 1), rB, cB + hstep + kstepB, voffB);
        PG8_WAIT_V(6); PG8_BAR;
    }
    for (;;) {
        const bool has_next = S.next(ui + 1, nxt);
        const unsigned nA = has_next ? (unsigned)nxt.pm * tstep : cA, nB = has_next ? (unsigned)nxt.pn * tstep : cB;
        for (int t = 0; t < nt; t += 2) {
            const bool last = (t == nt - 2);
            const unsigned a1 = cA + (unsigned)(t + 1) * kstep;
            const unsigned a2 = last ? nA : cA + (unsigned)(t + 2) * kstep, b2 = last ? nB : cB + (unsigned)(t + 2) * kstepB;
            const unsigned a3 = a2 + kstep, b3 = b2 + kstepB;
            if (last && has_next) S.a_ready(nxt);
            if constexpr (Epi::LDS_SCALES) { if (last) {
                const unsigned so_ = (wid < 4) ? E.row_off + (unsigned)cur.pm * 1024u : E.col_off + (unsigned)cur.pn * 1024u;
                __builtin_amdgcn_raw_ptr_buffer_load_lds(rS, (PG8_LAS void*)(lds + 131072 + wid * 256), 4, (int)voffS, (int)so_, 0, 0); } }
            if constexpr (SP2) {
            PG8_LDB(B0, 0, 0); PG8_LDB(B1, 0, 1); PG8_SCHED; PG8_LDA(At, 0, 0); PG8_STAGE(PG8_SA(1, 1), rA, a1 + hstep, voffA);
            PG8_WAIT_V(8); PG8_WAIT_L(0); PG8_BAR; PG8_MMA(0, 0, At, B0); PG8_MMA(0, 1, At, B1); PG8_BAR; PG8_SCHED;
            PG8_LDA(At, 0, 1); PG8_STAGE(PG8_SB(0, 0), rB, b2, voffB); PG8_STAGE(PG8_SB(0, 1), rB, b2 + hstep, voffB); PG8_STAGE(PG8_SA(0, 0), rA, a2, voffA);
            PG8_WAIT_V(8); PG8_WAIT_L(0); PG8_BAR; PG8_MMA(1, 0, At, B0); PG8_MMA(1, 1, At, B1); PG8_BAR; PG8_SCHED;
            PG8_LDB(B0, 1, 0); PG8_LDB(B1, 1, 1); PG8_SCHED; PG8_LDA(At, 1, 0); PG8_STAGE(PG8_SA(0, 1), rA, a2 + hstep, voffA);
            PG8_WAIT_V(8); PG8_WAIT_L(0); PG8_BAR; PG8_MMA(0, 0, At, B0); PG8_MMA(0, 1, At, B1); PG8_BAR; PG8_SCHED;
            PG8_LDA(At, 1, 1); PG8_STAGE(PG8_SB(1, 0), rB, b3, voffB); PG8_STAGE(PG8_SB(1, 1), rB, b3 + hstep, voffB); PG8_STAGE(PG8_SA(1, 0), rA, a3, voffA);
            PG8_WAIT_V(8); PG8_WAIT_L(0); PG8_BAR; PG8_MMA(1, 0, At, B0); PG8_MMA(1, 1, At, B1); PG8_BAR; PG8_SCHED;
            } else {
            PG8_LDB(B0, 0, 0); PG8_SCHED; PG8_LDA(At, 0, 0); PG8_STAGE(PG8_SA(1, 1), rA, a1 + hstep, voffA);
            PG8_WAIT_L(8); PG8_BAR; PG8_WAIT_L(0); PG8_MMA(0, 0, At, B0); PG8_BAR; PG8_SCHED;
            PG8_LDB(B1, 0, 1); PG8_STAGE(PG8_SB(0, 0), rB, b2, voffB);
            PG8_BAR; PG8_WAIT_L(0); PG8_MMA(0, 1, At, B1); PG8_BAR;
            PG8_LDA(At, 0, 1); PG8_STAGE(PG8_SA(0, 0), rA, a2, voffA);
            PG8_BAR; PG8_WAIT_L(0); PG8_MMA(1, 0, At, B0); PG8_BAR; PG8_SCHED;
            PG8_STAGE(PG8_SB(0, 1), rB, b2 + hstep, voffB);
            PG8_WAIT_V(6); PG8_BAR; PG8_MMA(1, 1, At, B1); PG8_BAR;
            PG8_LDB(B0, 1, 0); PG8_SCHED; PG8_LDA(At, 1, 0); PG8_STAGE(PG8_SA(0, 1), rA, a2 + hstep, voffA);
            PG8_WAIT_L(8); PG8_BAR; PG8_WAIT_L(0); PG8_MMA(0, 0, At, B0); PG8_BAR; PG8_SCHED;
            PG8_LDB(B1, 1, 1); PG8_STAGE(PG8_SB(1, 0), rB, b3, voffB);
            PG8_BAR; PG8_WAIT_L(0); PG8_MMA(0, 1, At, B1); PG8_BAR;
            PG8_LDA(At, 1, 1); PG8_STAGE(PG8_SA(1, 0), rA, a3, voffA);
            PG8_BAR; PG8_WAIT_L(0); PG8_MMA(1, 0, At, B0); PG8_BAR; PG8_SCHED;
            PG8_STAGE(PG8_SB(1, 1), rB, b3 + hstep, voffB);
            PG8_WAIT_V(6); PG8_BAR; PG8_MMA(1, 1, At, B1); PG8_BAR;
            }
        }
        if constexpr (ESZ == 1) asm volatile("s_nop 15\n\ts_nop 15" ::: "memory");
        if constexpr (ALIGN_EPI) { if (wr == 0) PG8_BAR; }
        if constexpr (!Epi::AFTER_DRAIN) { Unit ue_ = cur; asm volatile("" : "+s"(ue_.pm), "+s"(ue_.pn));
            if constexpr (Epi::LDS_SCALES) E(acc, ue_, wr, wc, fr, fq, (const PG8_LAS float*)(lds + 131072)); else E(acc, ue_, wr, wc, fr, fq); S.done(cur); }
        if (!has_next) break;
#pragma unroll
        for (int a = 0; a < 2; ++a)
#pragma unroll
            for (int b = 0; b < 2; ++b)
#pragma unroll
                for (int m = 0; m < 4; ++m)
#pragma unroll
                    for (int n = 0; n < 2; ++n) { typedef double f64x2_ __attribute__((ext_vector_type(2))); f64x2_ z_; asm volatile("v_mov_b64 %0, 0" : "=v"(z_.x)); asm volatile("v_mov_b64 %0, 0" : "=v"(z_.y)); acc[a][b][m][n] = __builtin_bit_cast(f32x4, z_); }
        cur = nxt; cA = nA; cB = nB; ++ui;
        if constexpr (ALIGN_EPI) { if (wr == 1) PG8_BAR; }
    }
    PG8_WAIT_V(0);
    if constexpr (!ALIGN_EPI) { if (wr == 0) PG8_BAR; }
    PG8_BAR;
    if constexpr (Epi::AFTER_DRAIN) { E.fused(acc, cur, wr, wc, fr, fq, lds, wid, lane); S.done(cur); }
#undef PG8_SA
#undef PG8_SB
#undef PG8_STAGE
#undef PG8_LDA
#undef PG8_LDB
#undef PG8_MMA
#undef PG8_WAIT_V
#undef PG8_WAIT_L
#undef PG8_BAR
#undef PG8_SCHED
}
}
#define LAS __attribute__((address_space(3)))
#define XB_TMO      128
#define XB_XCNT(j)  (256  + 64 * (j))
#define XB_XSUB(j)  (1280 + 64 * (j))
#define XB_XGEN(j)  (2304 + 64 * (j))
#define XB_TOP      3328
#define XB_TOPGEN   3392
#define XCD_BAR_WORDS 3456
#define XB_SPIN_CAP (1u << 18)

__device__ __forceinline__ unsigned xb_ld(unsigned* p)              { return __hip_atomic_load(p, __ATOMIC_RELAXED, __HIP_MEMORY_SCOPE_AGENT); }
__device__ __forceinline__ unsigned xb_add(unsigned* p, unsigned v) { return __hip_atomic_fetch_add(p, v, __ATOMIC_RELAXED, __HIP_MEMORY_SCOPE_AGENT); }
__device__ __forceinline__ unsigned xb_xcc_id() { return (unsigned)__builtin_amdgcn_s_getreg((3 << 11) | 20) & 0xFu; }
#define XB_SPIN(cond, bar) do { unsigned _sp = 0; while (cond) { __builtin_amdgcn_s_sleep(1); \
    if ((++_sp & 255u) == 0u) { if (xb_ld(&(bar)[XB_TMO])) break; if (_sp > XB_SPIN_CAP) { atomicAdd(&(bar)[XB_TMO], 1u); break; } } } } while (0)

struct XcdBarrier {
    unsigned* bar; unsigned x; unsigned wv;
    volatile LAS unsigned* st;
};

__device__ __forceinline__ unsigned xb_lane() { return (unsigned)pg8::lane_id_fresh(); }
__device__ __forceinline__ XcdBarrier xcd_barrier_post(unsigned* bar, volatile LAS unsigned* st) {
    XcdBarrier b; b.bar = bar; b.x = xb_xcc_id(); b.st = st; b.wv = (unsigned)__builtin_amdgcn_readfirstlane((int)(threadIdx.x >> 6));
    if (threadIdx.x == 0) (void)xb_add(&bar[XB_XCNT(b.x)], 1u);
    return b;
}
__device__ __forceinline__ void xcd_barrier_complete(unsigned* bar, unsigned x, unsigned& nloc, unsigned& nx) {
    const unsigned G = gridDim.x * gridDim.y * gridDim.z;
    unsigned sum, cnt, mine, sp = 0u;
    for (;;) {
        sum = 0u; cnt = 0u; mine = 0u;
#pragma unroll
        for (unsigned j = 0; j < 16; ++j) { const unsigned c = xb_ld(&bar[XB_XCNT(j)]); sum += c; cnt += (c > 0u) ? 1u : 0u; mine = (j == x) ? c : mine; }
        if (sum == G) break;
        __builtin_amdgcn_s_sleep(1);
        if ((++sp & 255u) == 0u) { if (xb_ld(&bar[XB_TMO])) break; if (sp > XB_SPIN_CAP) { atomicAdd(&bar[XB_TMO], 1u); break; } }
    }
    nloc = mine > 0u ? mine : 1u; nx = cnt > 0u ? cnt : 1u;
}

__device__ __forceinline__ void xcd_barrier(const XcdBarrier& b) {
    asm volatile("s_waitcnt vmcnt(0)" ::: "memory");
    __syncthreads();
    if (b.wv == 0u && xb_lane() == 0u) {
        unsigned* bar = b.bar;
        __builtin_amdgcn_s_waitcnt(0);
        unsigned nloc = b.st[0], nx = b.st[1];
        if (nloc == 0u) { xcd_barrier_complete(bar, b.x, nloc, nx); b.st[0] = nloc; b.st[1] = nx; }
        const unsigned old = xb_add(&bar[XB_XSUB(b.x)], 1u);
        const unsigned gen = old / nloc;
        if (old + 1u == (gen + 1u) * nloc) {
            __builtin_amdgcn_fence(__ATOMIC_RELEASE, "agent");
            asm volatile("s_waitcnt vmcnt(0)" ::: "memory");
            const unsigned og = xb_add(&bar[XB_TOP], 1u);
            const unsigned tg = og / nx;
            if (og + 1u == (tg + 1u) * nx) xb_add(&bar[XB_TOPGEN], 1u);
            else XB_SPIN(xb_ld(&bar[XB_TOPGEN]) == tg, bar);
            __builtin_amdgcn_fence(__ATOMIC_ACQUIRE, "agent");
            xb_add(&bar[XB_XGEN(b.x)], 1u);
            asm volatile("s_waitcnt vmcnt(0)" ::: "memory");
        } else {
            XB_SPIN(xb_ld(&bar[XB_XGEN(b.x)]) == gen, bar);
            __builtin_amdgcn_fence(__ATOMIC_ACQUIRE, "agent");
            asm volatile("s_waitcnt vmcnt(0)" ::: "memory");
        }
    }
    __syncthreads();
}
constexpr int DM = 2048, DFF = 5632, SEQ = 2048, DEPTH = 4, NSEQ = 24, NTOK = NSEQ * SEQ;
constexpr int TC = 16384, NCHUNK = NTOK / TC;
constexpr int NH = 12, HD = 128, ATTW = 1536, QKVW = 13824, INW = 14336, POOLW = 512;
constexpr int NGU = 2 * DFF;
constexpr float LOG2E = 1.4426950408889634f;
constexpr float QSCALE = 0.08838834764831845f * LOG2E;
constexpr int NSTEPS = 1 + NCHUNK * DEPTH * 8 + 1;

constexpr size_t MiB = 1u << 20;
constexpr size_t WS_CTL = 0, WS_CM = 1 * MiB, CTL_ZERO_BYTES = 2 * MiB;
constexpr int CM_IN = 0, CM_GU = 65536;
static_assert(DEPTH * 14336 <= CM_GU && (size_t)(CM_GU + 2 * DEPTH * 11264) * 4 <= 1 * MiB, "column-maxima map");
#ifndef DUP_GU8
#define DUP_GU8 1
#endif
#ifndef DUP_IN8
#define DUP_IN8 1
#endif
#ifndef ATT_SPLIT
#define ATT_SPLIT 1024
#endif
#ifndef I8_POOLIN
#define I8_POOLIN 0
#endif
#ifndef I8GU_MASK
#define I8GU_MASK 0xFFu
#endif
constexpr size_t WS_SR = 4 * MiB + 512 * 1024;
constexpr size_t WS_SA = 4 * MiB + 256 * 1024;
constexpr size_t WS_LUT = 4 * MiB, WS_WPT = 5 * MiB, WS_LSE = 6 * MiB;
constexpr size_t WS_W = 16 * MiB, W_LAYER = 196 * MiB;
constexpr size_t WO_GU0 = 0, WO_GU1 = 44 * MiB, WO_D0 = 88 * MiB, WO_D1 = 110 * MiB, WO_IN = 132 * MiB  , WO_INU = 160 * MiB  , WO_OUT = 188 * MiB;
constexpr float W8_SCALE = 64.0f;
constexpr size_t WS_XB = 800 * MiB, WS_H = 992 * MiB, WS_OG = WS_H, WS_Z = 1168 * MiB, WS_MIX = 1616 * MiB, WS_SS = 1680 * MiB, WS_XB8 = 1760 * MiB, WS_END = 1856 * MiB;
static_assert((size_t)NGU * DM * 2 == 44 * MiB && (size_t)DM * DFF * 2 == 22 * MiB && (size_t)INW * DM * 2 == 56 * MiB && (size_t)DM * DM * 2 == 8 * MiB, "weight map");
static_assert((size_t)NTOK * DM * 2 == 192 * MiB && (size_t)TC * DFF * 2 == 176 * MiB && (size_t)TC * INW * 2 == 448 * MiB && (size_t)TC * DM * 2 == 64 * MiB && (size_t)TC * 3 * ATTW * 2 <= 176 * MiB, "activation map");
static_assert(13 * (size_t)NTOK * 32 * 4 <= 80 * MiB && (size_t)TC * 36 * 4 <= 10 * MiB, "small buffers");
constexpr int CW_BAR = 4096;

constexpr int LDS_BYTES = 147456;
constexpr int ATT_K = 0, ATT_KP = 272, ATT_V = 256 * ATT_KP, ATT_VP = 288, ATT_LUT = ATT_V + 256 * ATT_VP;
constexpr int MISC_OFF = 146432;
static_assert(ATT_LUT + 768 <= MISC_OFF && MISC_OFF + 64 <= LDS_BYTES, "LDS map");

#define GAS __attribute__((address_space(1)))
typedef unsigned short bf16;
typedef unsigned u32x4 __attribute__((ext_vector_type(4)));
typedef unsigned u32x2 __attribute__((ext_vector_type(2)));
typedef float f32x4 __attribute__((ext_vector_type(4)));
typedef short bf16x8 __attribute__((ext_vector_type(8)));
typedef short s16x4 __attribute__((ext_vector_type(4)));
using pg8::cvt_pk_bf16;
#define LDS_WAIT() asm volatile("s_waitcnt lgkmcnt(0)" ::: "memory")
#define LDS_BARRIER() asm volatile("s_waitcnt lgkmcnt(0)\n\ts_barrier" ::: "memory")
__device__ __forceinline__ float bf_lo(unsigned w) { return __uint_as_float(w << 16); }
__device__ __forceinline__ float bf_hi(unsigned w) { return __uint_as_float(w & 0xffff0000u); }
__device__ __forceinline__ float wave_sum(float v) {
#pragma unroll
    for (int o = 1; o < 64; o <<= 1) v += __shfl_xor(v, o);
    return v;
}

#define W_OFF(n, kb, Kb) (PG8_B_BLOCKED ? pg8::bblk_off((n), (kb), (Kb)) : ((size_t)(n) * (size_t)(Kb) + (size_t)(kb)))
struct CvtItem { const float* src; const float* gk; unsigned char* dst; float* cm; int ldn, k0, c0, ldk, r0, fp8  ; float cs; };
__device__ __forceinline__ void cvt_colmax(const CvtItem& I, const float (&lv)[32], int lane) {
    float m = 0.f;
#pragma unroll
    for (int i = 0; i < 32; ++i) { const int kk = 2 * i + (lane >> 5); m = fmaxf(m, fabsf(lv[i] * (I.gk ? I.gk[I.k0 + kk] : 1.0f))); }
    m = fmaxf(m, __shfl_xor(m, 32));
    if (lane < 32) atomicMax((unsigned*)(I.cm + I.r0 + lane), __float_as_uint(m));
}
__device__ __forceinline__ void cvt_load(const CvtItem& I, float (&lv)[32], int lane) {
#pragma unroll
    for (int i = 0; i < 32; ++i) { const int kk = 2 * i + (lane >> 5); lv[i] = I.src[(size_t)(I.k0 + kk) * I.ldn + I.c0 + (lane & 31)]; }
}
__device__ __forceinline__ void cvt_store(const CvtItem& I, const float (&lv)[32], LAS float* scr, int lane) {
#pragma unroll
    for (int i = 0; i < 32; ++i) { const int kk = 2 * i + (lane >> 5); scr[kk * 33 + (lane & 31)] = lv[i]; }
    const int c = lane & 7;
    float gs[8];
#pragma unroll
    for (int j = 0; j < 8; ++j) gs[j] = I.gk ? I.gk[I.k0 + 8 * c + j] * I.cs : I.cs;
    LDS_WAIT(); asm volatile("" ::: "memory");
#pragma unroll
    for (int j = 0; j < 4; ++j) { const int n = (lane >> 3) + 8 * j; const LAS float* s = scr + (8 * c) * 33 + n;
        float v[8];
#pragma unroll
        for (int q = 0; q < 8; ++q) v[q] = s[q * 33] * gs[q];
        if (I.fp8) { const float cmv = I.cm[I.r0 + n], inv = cmv > 0.f ? 127.0f / cmv : 0.f; int q8[8];
#pragma unroll
            for (int q = 0; q < 8; ++q) { int t = (int)__builtin_rintf(v[q] * inv); t = t < -127 ? -127 : (t > 127 ? 127 : t); q8[q] = t & 0xff; }
            u32x2 o; o.x = (unsigned)q8[0] | ((unsigned)q8[1] << 8) | ((unsigned)q8[2] << 16) | ((unsigned)q8[3] << 24); o.y = (unsigned)q8[4] | ((unsigned)q8[5] << 8) | ((unsigned)q8[6] << 16) | ((unsigned)q8[7] << 24);
            *(u32x2*)(I.dst + W_OFF(I.r0 + n, I.k0 + 8 * c, I.ldk)) = o; }
        else { u32x4 o; o.x = cvt_pk_bf16(v[0], v[1]); o.y = cvt_pk_bf16(v[2], v[3]); o.z = cvt_pk_bf16(v[4], v[5]); o.w = cvt_pk_bf16(v[6], v[7]);
            *(u32x4*)(I.dst + W_OFF(I.r0 + n, (I.k0 + 8 * c) * 2, I.ldk * 2)) = o; } }
    LDS_WAIT(); asm volatile("" ::: "memory");
}
__device__ __forceinline__ void cvt_store8(const CvtItem& I, const float (&lv)[32], LAS float* scr, int lane, float cmv) {
#pragma unroll
    for (int i = 0; i < 32; ++i) { const int kk = 2 * i + (lane >> 5); scr[kk * 33 + (lane & 31)] = lv[i]; }
    const int c = lane & 7;
    float gs[8];
#pragma unroll
    for (int j = 0; j < 8; ++j) gs[j] = I.gk[I.k0 + 8 * c + j];
    LDS_WAIT(); asm volatile("" ::: "memory");
#pragma unroll
    for (int j = 0; j < 4; ++j) { const int n = (lane >> 3) + 8 * j; const LAS float* s = scr + (8 * c) * 33 + n;
        const float cmn = __shfl(cmv, n), inv = cmn > 0.f ? 127.0f / cmn : 0.f; int q8[8];
#pragma unroll
        for (int q = 0; q < 8; ++q) { int t = (int)__builtin_rintf(s[q * 33] * gs[q] * inv); t = t < -127 ? -127 : (t > 127 ? 127 : t); q8[q] = t & 0xff; }
        u32x2 o; o.x = (unsigned)q8[0] | ((unsigned)q8[1] << 8) | ((unsigned)q8[2] << 16) | ((unsigned)q8[3] << 24); o.y = (unsigned)q8[4] | ((unsigned)q8[5] << 8) | ((unsigned)q8[6] << 16) | ((unsigned)q8[7] << 24);
        *(u32x2*)(I.dst + W_OFF(I.r0 + n, I.k0 + 8 * c, I.ldk)) = o; }
    LDS_WAIT(); asm volatile("" ::: "memory");
}
__device__ __forceinline__ int t5_bucket(int rel) {
    const int n = rel < 0 ? -rel : rel; int b;
    if (n < 8) b = n; else if (n < 15) b = 8; else if (n < 27) b = 9; else if (n < 50) b = 10; else if (n < 91) b = 11; else if (n < 166) b = 12; else if (n < 305) b = 13; else if (n < 559) b = 14; else b = 15;
    return b + (rel > 0 ? 16 : 0);
}
struct Ptrs {
    const float *x_prompt, *x_sample, *norm_g, *ffn_gate, *ffn_up, *ffn_down, *w_in, *w_pool, *pool_scale, *w_out, *rel_bias, *final_g;
    float* out; unsigned char* ws;
};
__device__ __forceinline__ void prologue(const Ptrs& P, LAS unsigned char* lds, int tid, int lane, int wave, int G, int pass) {
    LAS float* scr = (LAS float*)(lds + wave * 8448);
    const int gw = blockIdx.x * 8 + wave, NGW = G * 8;
    constexpr int I_GU = 32 * 352, I_D = 88 * 64, I_IN = 32 * 448, I_OUT = 32 * 64, I_LAYER = 2 * I_GU + 2 * I_D + I_IN + I_OUT;
    auto decode = [&](int it) -> CvtItem {
        CvtItem I; const int l = it / I_LAYER; int r = it % I_LAYER;
        unsigned char* wl = P.ws + WS_W + (size_t)l * W_LAYER; I.fp8 = 0; I.cs = 1.0f; I.cm = nullptr; float* CM = (float*)(P.ws + WS_CM);
        if (r < 2 * I_GU) { const int j = r / I_GU; r %= I_GU; const int kb = r / 352, nb = r % 352, n0 = 32 * nb, pn = n0 >> 8, within = n0 & 255;
            I.src = ((within < 128) ? P.ffn_gate : P.ffn_up) + (size_t)(l * 2 + j) * DM * DFF; I.ldn = DFF; I.k0 = 64 * kb; I.c0 = 128 * pn + (within & 127);
            I.dst = wl + (j ? WO_GU1 : WO_GU0); I.ldk = DM; I.r0 = n0; I.gk = P.norm_g + (size_t)(l * 3 + 2 * j) * DM;
            if ((I8GU_MASK >> (l * 2 + j)) & 1u) { I.fp8 = 2; I.cm = CM + CM_GU + (l * 2 + j) * NGU; }
            return I; }
        r -= 2 * I_GU;
        if (r < 2 * I_D) { const int j = r / I_D; r %= I_D; const int kb = r / 64, nb = r % 64;
            I.src = P.ffn_down + (size_t)(l * 2 + j) * DFF * DM; I.ldn = DM; I.k0 = 64 * kb; I.c0 = 32 * nb; I.dst = wl + (j ? WO_D1 : WO_D0); I.ldk = DFF; I.r0 = 32 * nb; I.gk = nullptr; return I; }
        r -= 2 * I_D;
        if (r < I_IN) { const int kb = r / 448, nb = r % 448, n0 = 32 * nb;
            I.src = P.w_in + (size_t)l * DM * INW; I.ldn = INW; I.k0 = 64 * kb; I.c0 = n0; I.ldk = DM; I.gk = P.norm_g + (size_t)(l * 3 + 1) * DM;
#if I8_POOLIN
            I.dst = wl + WO_IN; I.r0 = n0; I.fp8 = 2; I.cm = CM + CM_IN + l * INW;
#else
            if (n0 < QKVW) { I.dst = wl + WO_IN; I.r0 = n0; I.fp8 = 2; I.cm = CM + CM_IN + l * INW; } else { I.dst = wl + WO_INU; I.r0 = n0 - QKVW; }
#endif
            return I; }
        r -= I_IN;
        { const int kb = r / 64, nb = r % 64;
            I.src = P.w_out + (size_t)l * DM * DM; I.ldn = DM; I.k0 = 64 * kb; I.c0 = 32 * nb; I.dst = wl + WO_OUT; I.ldk = DM; I.r0 = 32 * nb; I.gk = nullptr; return I; }
    };
    {
        LAS float* cmx = (LAS float*)(lds + 69632);
        constexpr int S_LAYER = 2 * 352 + 432;
        for (int sidx = blockIdx.x; sidx < DEPTH * S_LAYER; sidx += G) {
            const int l = sidx / S_LAYER, r = sidx % S_LAYER; int itb, kstride;
            if (r < 704) { const int j = r / 352; if (!((I8GU_MASK >> (l * 2 + j)) & 1u)) continue; itb = l * I_LAYER + j * I_GU + (r % 352); kstride = 352; }
            else { itb = l * I_LAYER + 2 * I_GU + 2 * I_D + (r - 704); kstride = 448; }
            float lv[4][32];
#pragma unroll
            for (int b = 0; b < 4; ++b) { const CvtItem I = decode(itb + (4 * wave + b) * kstride); cvt_load(I, lv[b], lane); }
            float m = 0.f;
#pragma unroll
            for (int b = 0; b < 4; ++b) { const CvtItem I = decode(itb + (4 * wave + b) * kstride);
#pragma unroll
                for (int i = 0; i < 32; ++i) { const int kk = 2 * i + (lane >> 5); m = fmaxf(m, fabsf(lv[b][i] * I.gk[I.k0 + kk])); } }
            m = fmaxf(m, __shfl_xor(m, 32));
            if (lane < 32) cmx[wave * 32 + lane] = m;
            __syncthreads();
            float cmv = 0.f;
#pragma unroll
            for (int w = 0; w < 8; ++w) cmv = fmaxf(cmv, cmx[w * 32 + (lane & 31)]);
            { const CvtItem I = decode(itb); if (wave == 0 && lane < 32) I.cm[I.r0 + lane] = cmv; }
#pragma unroll
            for (int b = 0; b < 4; ++b) { const CvtItem I = decode(itb + (4 * wave + b) * kstride); cvt_store8(I, lv[b], scr, lane, cmv); }
            __syncthreads();
        }
    }
    {
        constexpr int NIT = DEPTH * I_LAYER;
        auto next16 = [&](int it) -> int { while (it < NIT && decode(it).fp8 == 2) it += NGW; return it; };
        int itA = next16(gw), itB = (itA < NIT) ? next16(itA + NGW) : NIT; float lvA[32], lvB[32]; CvtItem curA, curB;
        if (itA < NIT) { curA = decode(itA); cvt_load(curA, lvA, lane); } else curA = decode(0);
        curB = curA; if (itB < NIT) { curB = decode(itB); cvt_load(curB, lvB, lane); }
        while (itA < NIT) {
            float lcA[32], lcB[32];
#pragma unroll
            for (int i = 0; i < 32; ++i) { lcA[i] = lvA[i]; lcB[i] = lvB[i]; }
            const int itA2 = (itB < NIT) ? next16(itB + NGW) : NIT, itB2 = (itA2 < NIT) ? next16(itA2 + NGW) : NIT; CvtItem nA = curA, nB = curB;
            if (itA2 < NIT) { nA = decode(itA2); cvt_load(nA, lvA, lane); }
            if (itB2 < NIT) { nB = decode(itB2); cvt_load(nB, lvB, lane); }
            asm volatile("" ::: "memory");
            cvt_store(curA, lcA, scr, lane);
            if (itB < NIT) cvt_store(curB, lcB, scr, lane);
            curA = nA; curB = nB; itA = itA2; itB = itB2;
        }
    }
    bf16* XB = (bf16*)(P.ws + WS_XB); float* SS = (float*)(P.ws + WS_SS);
    for (int rowa = gw; rowa < NTOK; rowa += 2 * NGW) {
        f32x4 v[2][8]; float s[2];
#pragma unroll
        for (int h = 0; h < 2; ++h) { const int row = rowa + h * NGW; s[h] = 0.f;
            if (row < NTOK) { const float* xr = (row < 16 * SEQ) ? P.x_prompt + (size_t)row * DM : P.x_sample + (size_t)(row - 16 * SEQ) * DM;
#pragma unroll
                for (int j = 0; j < 8; ++j) v[h][j] = *(const f32x4*)(xr + 4 * lane + 256 * j); }
            else {
#pragma unroll
                for (int j = 0; j < 8; ++j) v[h][j] = (f32x4){0.f, 0.f, 0.f, 0.f}; } }
#pragma unroll
        for (int h = 0; h < 2; ++h) { const int row = rowa + h * NGW; if (row >= NTOK) continue;
#pragma unroll
            for (int j = 0; j < 8; ++j) s[h] += (v[h][j][0] * v[h][j][0] + v[h][j][1] * v[h][j][1]) + (v[h][j][2] * v[h][j][2] + v[h][j][3] * v[h][j][3]);
            s[h] = wave_sum(s[h]);
#pragma unroll
            for (int j = 0; j < 8; ++j) { u32x2 o; o.x = cvt_pk_bf16(v[h][j][0], v[h][j][1]); o.y = cvt_pk_bf16(v[h][j][2], v[h][j][3]); *(u32x2*)(XB + (size_t)row * DM + 4 * lane + 256 * j) = o; }
            if (lane < 32) SS[(size_t)row * 32 + lane] = (lane == 0) ? s[h] : 0.f; }
    }
    float* LUT = (float*)(P.ws + WS_LUT);
    for (int i = blockIdx.x * 512 + tid; i < 36 * 192; i += G * 512) { const int gh = i / 192, idx = i % 192, d64 = idx - 16, g = gh / 12, dil = (g == 0) ? 1 : (g == 1 ? 4 : 16);
        LUT[i] = (d64 >= 0 && d64 <= 128) ? P.rel_bias[t5_bucket((d64 - 64) * dil) * 36 + gh] * LOG2E : -1e30f; }
    bf16* WPT = (bf16*)(P.ws + WS_WPT);
    for (int i = blockIdx.x * 512 + tid; i < DEPTH * 4 * 128 * 128; i += G * 512) { const int c = i & 127, e = (i >> 7) & 127, lg = i >> 14;
        WPT[i] = (bf16)(cvt_pk_bf16(P.w_pool[(size_t)lg * 16384 + c * 128 + e], 0.f) & 0xffffu); }
}

#ifndef QR
#define QR 4
#endif
template <bool WR> __device__ __forceinline__ void quant_rows(const bf16* __restrict__ xb, unsigned char* __restrict__ x8, float* __restrict__ sa, float* __restrict__ sr, const float* __restrict__ ssp, int lane, int wave, int G_) {
    const int gw = blockIdx.x * 8 + wave, NGW = G_ * 8;
    for (int rb = gw; rb < TC; rb += QR * NGW) {
        u32x4 v[QR][4]; float am[QR];
#pragma unroll
        for (int q = 0; q < QR; ++q) { const int row = rb + q * NGW;
#pragma unroll
            for (int j = 0; j < 4; ++j) v[q][j] = (row < TC) ? *(const u32x4*)(xb + (size_t)row * DM + 8 * lane + 512 * j) : (u32x4){0u, 0u, 0u, 0u}; }
#pragma unroll
        for (int q = 0; q < QR; ++q) { float a = 0.f;
#pragma unroll
            for (int j = 0; j < 4; ++j)
#pragma unroll
                for (int k = 0; k < 4; ++k) a = fmaxf(a, fmaxf(fabsf(bf_lo(v[q][j][k])), fabsf(bf_hi(v[q][j][k]))));
#pragma unroll
            for (int o = 1; o < 64; o <<= 1) a = fmaxf(a, __shfl_xor(a, o));
            am[q] = a; }
#pragma unroll
        for (int q = 0; q < QR; ++q) { const int row = rb + q * NGW; if (row >= TC) continue;
            const float inv = am[q] > 0.f ? 127.0f / am[q] : 0.f;
            { float sp = (lane < 32) ? ssp[(size_t)row * 32 + lane] : 0.f;
#pragma unroll
              for (int o = 1; o < 32; o <<= 1) sp += __shfl_xor(sp, o);
              const float rstd = __builtin_amdgcn_rsqf(sp * pg8::INV_D + pg8::RMS_EPS);
              if (lane == 0) { sa[row] = am[q] * (1.0f / 127.0f) * rstd; if (WR) sr[row] = rstd; } }
#pragma unroll
            for (int j = 0; j < 4; ++j) { u32x2 o; int q8[8];
#pragma unroll
                for (int k = 0; k < 4; ++k) { int t0 = (int)__builtin_rintf(bf_lo(v[q][j][k]) * inv), t1 = (int)__builtin_rintf(bf_hi(v[q][j][k]) * inv);
                    t0 = t0 < -127 ? -127 : (t0 > 127 ? 127 : t0); t1 = t1 < -127 ? -127 : (t1 > 127 ? 127 : t1); q8[2 * k] = t0 & 0xff; q8[2 * k + 1] = t1 & 0xff; }
                o.x = (unsigned)q8[0] | ((unsigned)q8[1] << 8) | ((unsigned)q8[2] << 16) | ((unsigned)q8[3] << 24); o.y = (unsigned)q8[4] | ((unsigned)q8[5] << 8) | ((unsigned)q8[6] << 16) | ((unsigned)q8[7] << 24);
                *(u32x2*)(x8 + (size_t)row * DM + 8 * lane + 512 * j) = o; } }
    }
}

struct AttnUnit { const bf16* zb; size_t tstride; int L, i0, dil, gh, tokbase, nsteps; };
template <int MODE> __device__ __forceinline__ AttnUnit attn_decode(const bf16* z, int u) {
    AttnUnit a; int bh, g, c, seg;
    if (MODE) { bh = u >> 3; g = 0; c = 0; seg = u & 7; a.dil = 1; a.nsteps = 2; }
    else if (u < 768) { bh = u >> 3; g = 1; c = (u & 7) >> 1; seg = u & 1; a.dil = 4; a.nsteps = 2; }
    else { const int v = u - 768; bh = v >> 4; g = 2; c = v & 15; seg = 0; a.dil = 16; a.nsteps = 1; }
    const int b = bh / NH, h = bh % NH;
    a.L = SEQ / a.dil; a.i0 = seg * 256; a.tstride = (size_t)a.dil * INW; a.gh = g * NH + h; a.tokbase = b * SEQ + c;
    a.zb = z + (size_t)a.tokbase * INW + g * 4608 + h * HD;
    return a;
}
struct AttnRegs { u32x4 kv[8], vv[8]; bf16x8 qf[4]; float lutv; };
__device__ __forceinline__ void attn_issue(const AttnUnit& a, int i0s, bool first, AttnRegs& R, const float* __restrict__ lutg, int tid, int lane, int wave) {
    const int kstart = i0s - 64, sb = i0s & 255;
#pragma unroll
    for (int it = 0; it < 8; ++it) { const int id = tid + 512 * it, slot = id >> 4, cc = id & 15, p = (slot - sb) & 255, ki = kstart + p;
        R.kv[it] = (u32x4){0u, 0u, 0u, 0u}; R.vv[it] = (u32x4){0u, 0u, 0u, 0u};
        if ((first || p >= 128) && ki >= 0 && ki < a.L) { const bf16* q = a.zb + (size_t)ki * a.tstride + cc * 8; R.kv[it] = *(const u32x4*)(q + 1536); R.vv[it] = *(const u32x4*)(q + 3072); } }
    const bf16* qp = a.zb + (size_t)(i0s + 16 * wave + (lane & 15)) * a.tstride + 8 * (lane >> 4);
#pragma unroll
    for (int ks = 0; ks < 4; ++ks) R.qf[ks] = *(const bf16x8*)(qp + 32 * ks);
    R.lutv = (tid < 192) ? lutg[a.gh * 192 + tid] : 0.f;
}
template <int MODE> __device__ __forceinline__ void attn_phase(const bf16* __restrict__ z, bf16* og, float* lse, bf16* __restrict__ mix, const float* __restrict__ lutg, LAS unsigned char* lds, int tid, int lane, int wave, int u0, int G_, int nunits) {
    if (u0 >= nunits) return;
    const int qi = lane & 15, G = lane >> 4;
    LAS unsigned char* Kl = lds + ATT_K; LAS unsigned char* Vl = lds + ATT_V; LAS float* lut = (LAS float*)(lds + ATT_LUT);
    int u = u0, st = 0; AttnUnit cur = attn_decode<MODE>(z, u); AttnRegs R; attn_issue(cur, cur.i0, true, R, lutg, tid, lane, wave);
#if defined(DUP_ATTX)
    int reps_left = (MODE == DUP_ATTX_MODE) ? DUP_ATTX - 1 : 0;
#endif
    for (;;) {
        const int i0s = cur.i0 + 128 * st, sb = i0s & 255; const bool first = (st == 0);
#pragma unroll
        for (int it = 0; it < 8; ++it) { const int id = tid + 512 * it, slot = id >> 4, cc = id & 15, p = (slot - sb) & 255;
            if (first || p >= 128) { *(LAS u32x4*)(Kl + slot * ATT_KP + cc * 16) = R.kv[it]; *(LAS u32x4*)(Vl + slot * ATT_VP + cc * 16) = R.vv[it]; } }
        if (tid < 192) lut[tid] = R.lutv;
        bf16x8 qf[4];
#pragma unroll
        for (int ks = 0; ks < 4; ++ks) qf[ks] = R.qf[ks];
        LDS_BARRIER();
        int un = u, stn = st + 1; AttnUnit nxt = cur; bool has_next = true;
        if (stn >= cur.nsteps) { un = u + G_; stn = 0; has_next = un < nunits;
#if defined(DUP_ATTX)
            if (!has_next && reps_left > 0) { --reps_left; un = u0; has_next = true; }
#endif
            if (has_next) nxt = attn_decode<MODE>(z, un); }
        if (has_next) attn_issue(nxt, nxt.i0 + 128 * stn, stn == 0, R, lutg, tid, lane, wave);
        asm volatile("" ::: "memory");
        const int L = cur.L, kw0 = 16 * wave, kbase = i0s - 64 + kw0;
        const size_t tokrow = (size_t)cur.tokbase + (size_t)(i0s + 16 * wave + qi) * cur.dil;
        f32x4 s[9];
        {
            const int rb = sb + kw0 + qi;
            const LAS unsigned char* kcol = Kl + 16 * G;
            bf16x8 ka[2][4];
#pragma unroll
            for (int ks = 0; ks < 4; ++ks) ka[0][ks] = *(const LAS bf16x8*)(kcol + (rb & 255) * ATT_KP + 64 * ks);
#pragma unroll
            for (int kt = 0; kt < 9; ++kt) {
                if (kt + 1 < 9) {
#pragma unroll
                    for (int ks = 0; ks < 4; ++ks) ka[(kt + 1) & 1][ks] = *(const LAS bf16x8*)(kcol + ((rb + 16 * (kt + 1)) & 255) * ATT_KP + 64 * ks); }
                f32x4 a4 = (f32x4){0.f, 0.f, 0.f, 0.f};
#pragma unroll
                for (int ks = 0; ks < 4; ++ks) a4 = __builtin_amdgcn_mfma_f32_16x16x32_bf16(ka[kt & 1][ks], qf[ks], a4, 0, 0, 0);
                s[kt] = a4; }
        }
        float m = -3.0e38f;
        {
            const LAS float* lb = lut + (4 * G - qi + 16);
            float bv[9][4];
#pragma unroll
            for (int kt = 0; kt < 9; ++kt)
#pragma unroll
                for (int rr = 0; rr < 4; ++rr) bv[kt][rr] = lb[16 * kt + rr];
#pragma unroll
            for (int kt = 0; kt < 9; ++kt) { const bool tv = (kbase + 16 * kt >= 0) && (kbase + 16 * kt < L);
#pragma unroll
                for (int rr = 0; rr < 4; ++rr) { const float v = tv ? s[kt][rr] + bv[kt][rr] : -1e30f; s[kt][rr] = v; m = fmaxf(m, v); } }
        }
        m = fmaxf(m, __shfl_xor(m, 16)); m = fmaxf(m, __shfl_xor(m, 32));
        float lsum = 0.f;
#pragma unroll
        for (int kt = 0; kt < 9; ++kt)
#pragma unroll
            for (int rr = 0; rr < 4; ++rr) { const float p = __builtin_amdgcn_exp2f(s[kt][rr] - m); s[kt][rr] = p; lsum += p; }
        lsum += __shfl_xor(lsum, 16); lsum += __shfl_xor(lsum, 32);
        u32x2 o1[8], o2[8]; float l1 = 0.f, l2 = 0.f;
        if (MODE == 1) {
            const bf16* gp = og + tokrow * (3 * ATTW) + cur.gh * HD + 4 * G;
#pragma unroll
            for (int db = 0; db < 8; ++db) { o1[db] = *(const u32x2*)(gp + ATTW + 16 * db); o2[db] = *(const u32x2*)(gp + 2 * ATTW + 16 * db); }
            l1 = lse[tokrow * 36 + 12 + cur.gh]; l2 = lse[tokrow * 36 + 24 + cur.gh];
            asm volatile("" ::: "memory");
        }
        f32x4 o[8];
#pragma unroll
        for (int db = 0; db < 8; ++db) o[db] = (f32x4){0.f, 0.f, 0.f, 0.f};
#pragma unroll
        for (int kp = 0; kp < 5; ++kp) {
            u32x4 pw; pw.x = cvt_pk_bf16(s[2 * kp][0], s[2 * kp][1]); pw.y = cvt_pk_bf16(s[2 * kp][2], s[2 * kp][3]);
            if (kp < 4) { pw.z = cvt_pk_bf16(s[2 * kp + 1][0], s[2 * kp + 1][1]); pw.w = cvt_pk_bf16(s[2 * kp + 1][2], s[2 * kp + 1][3]); } else { pw.z = 0u; pw.w = 0u; }
            const bf16x8 pb = __builtin_bit_cast(bf16x8, pw);
            const int rowA = (sb + kw0 + 32 * kp + 4 * G + (qi >> 2)) & 255, rowB = (rowA + 16) & 255;
            const LAS unsigned char* pa = Vl + rowA * ATT_VP + (qi & 3) * 8; const LAS unsigned char* pbv = Vl + rowB * ATT_VP + (qi & 3) * 8;
#pragma unroll
            for (int db = 0; db < 8; ++db) {
                const s16x4 t0 = __builtin_bit_cast(s16x4, __builtin_amdgcn_ds_read_tr16_b64_v4i16((LAS s16x4*)(pa + db * 32)));
                const s16x4 t1 = __builtin_bit_cast(s16x4, __builtin_amdgcn_ds_read_tr16_b64_v4i16((LAS s16x4*)(pbv + db * 32)));
                const bf16x8 a = (bf16x8){t0[0], t0[1], t0[2], t0[3], t1[0], t1[1], t1[2], t1[3]};
                o[db] = __builtin_amdgcn_mfma_f32_16x16x32_bf16(a, pb, o[db], 0, 0, 0); }
        }
        const float inv = __builtin_amdgcn_rcpf(lsum);
        if (MODE == 0) {
            bf16* op = og + tokrow * (3 * ATTW) + cur.gh * HD + 4 * G;
#pragma unroll
            for (int db = 0; db < 8; ++db) { u32x2 w; w.x = cvt_pk_bf16(o[db][0] * inv, o[db][1] * inv); w.y = cvt_pk_bf16(o[db][2] * inv, o[db][3] * inv); *(u32x2*)(op + 16 * db) = w; }
            if (G == 0) lse[tokrow * 36 + cur.gh] = m + __builtin_amdgcn_logf(lsum);
        } else {
            const float l0 = m + __builtin_amdgcn_logf(lsum), mx = fmaxf(l0, fmaxf(l1, l2));
            float w0 = __builtin_amdgcn_exp2f(l0 - mx), w1 = __builtin_amdgcn_exp2f(l1 - mx), w2 = __builtin_amdgcn_exp2f(l2 - mx);
            const float wi = __builtin_amdgcn_rcpf(w0 + w1 + w2); w0 *= wi * inv; w1 *= wi; w2 *= wi;
            bf16* mp = mix + tokrow * DM + cur.gh * HD + 4 * G;
#pragma unroll
            for (int db = 0; db < 8; ++db) { u32x2 w;
                w.x = cvt_pk_bf16(w0 * o[db][0] + w1 * bf_lo(o1[db].x) + w2 * bf_lo(o2[db].x), w0 * o[db][1] + w1 * bf_hi(o1[db].x) + w2 * bf_hi(o2[db].x));
                w.y = cvt_pk_bf16(w0 * o[db][2] + w1 * bf_lo(o1[db].y) + w2 * bf_lo(o2[db].y), w0 * o[db][3] + w1 * bf_hi(o1[db].y) + w2 * bf_hi(o2[db].y));
                *(u32x2*)(mp + 16 * db) = w; }
        }
        LDS_BARRIER();
        if (!has_next) break;
        cur = nxt; u = un; st = stn;
    }
}

template <int HW> __device__ __forceinline__ void pool_task(const bf16* __restrict__ z, bf16* __restrict__ mix, const bf16* __restrict__ wpt, const float* __restrict__ pscale, int pg, int tile, int lane) {
    const int qi = lane & 15, Gq = lane >> 4, tt = tile * 16 + qi, spos = tt & (SEQ - 1);
    const int lo = (spos - HW) < 0 ? 0 : spos - HW, hi = (spos + HW + 1) > SEQ ? SEQ : spos + HW + 1; const float rc = 1.0f / (float)(hi - lo);
    const bf16* ub = z + (size_t)(tt - spos) * INW + QKVW + pg * 128 + 8 * Gq;
    bf16x8 df[4];
#pragma unroll
    for (int ks = 0; ks < 4; ++ks) { float acc[8];
#pragma unroll
        for (int k = 0; k < 8; ++k) acc[k] = 0.f;
        u32x4 sv;
#pragma unroll
        for (int w0 = 0; w0 < 2 * HW + 1; w0 += 9) {
            constexpr int NB = 9; u32x4 wv[NB];
#pragma unroll
            for (int w = 0; w < NB; ++w) if (w0 + w < 2 * HW + 1) { int sp = spos - HW + w0 + w; sp = sp < 0 ? 0 : (sp > SEQ - 1 ? SEQ - 1 : sp); wv[w] = *(const u32x4*)(ub + (size_t)sp * INW + 32 * ks); }
#pragma unroll
            for (int w = 0; w < NB; ++w) if (w0 + w < 2 * HW + 1) { const int sp = spos - HW + w0 + w; const float msk = (sp >= 0 && sp < SEQ) ? 1.0f : 0.0f;
                if (w0 + w == HW) sv = wv[w];
#pragma unroll
                for (int k = 0; k < 4; ++k) { acc[2 * k] += msk * bf_lo(wv[w][k]); acc[2 * k + 1] += msk * bf_hi(wv[w][k]); } }
            if (2 * HW + 1 > 9) asm volatile("" ::: "memory");
        }
        u32x4 dw;
#pragma unroll
        for (int k = 0; k < 4; ++k) dw[k] = cvt_pk_bf16(acc[2 * k] * rc - bf_lo(sv[k]), acc[2 * k + 1] * rc - bf_hi(sv[k]));
        df[ks] = __builtin_bit_cast(bf16x8, dw);
        asm volatile("" ::: "memory"); }
    const bf16* wb = wpt + (size_t)pg * 16384 + (size_t)qi * 128 + 8 * Gq;
    bf16* mp = mix + (size_t)tt * DM + ATTW + pg * 128 + 4 * Gq;
#pragma unroll
    for (int eb = 0; eb < 8; ++eb) { f32x4 a4 = (f32x4){0.f, 0.f, 0.f, 0.f};
#pragma unroll
        for (int ks = 0; ks < 4; ++ks) { const bf16x8 wf = *(const bf16x8*)(wb + (size_t)eb * 16 * 128 + 32 * ks); a4 = __builtin_amdgcn_mfma_f32_16x16x32_bf16(wf, df[ks], a4, 0, 0, 0); }
        const f32x4 ps = *(const f32x4*)(pscale + pg * 128 + 16 * eb + 4 * Gq);
        u32x2 w; w.x = cvt_pk_bf16(a4[0] * ps[0], a4[1] * ps[1]); w.y = cvt_pk_bf16(a4[2] * ps[2], a4[3] * ps[3]); *(u32x2*)(mp + 16 * eb) = w; }
}
__device__ __forceinline__ void pool_phase(const bf16* __restrict__ z, bf16* __restrict__ mix, const bf16* __restrict__ wpt  , const float* __restrict__ pscale  , int lane, int wave, int G_) {
    const int gw = blockIdx.x * 8 + wave, NGW = G_ * 8;
    for (int tile = (gw + 0 * (NGW / 4)) % NGW; tile < TC / 16; tile += NGW) pool_task<1>(z, mix, wpt, pscale, 0, tile, lane);
    for (int tile = (gw + 1 * (NGW / 4)) % NGW; tile < TC / 16; tile += NGW) pool_task<2>(z, mix, wpt, pscale, 1, tile, lane);
    for (int tile = (gw + 2 * (NGW / 4)) % NGW; tile < TC / 16; tile += NGW) pool_task<4>(z, mix, wpt, pscale, 2, tile, lane);
    for (int tile = (gw + 3 * (NGW / 4)) % NGW; tile < TC / 16; tile += NGW) pool_task<8>(z, mix, wpt, pscale, 3, tile, lane);
}

__device__ __forceinline__ void final_norm(float* out, const bf16* xbf, const float* ss, const float* fg, int lane, int wave, int G_) {
    const int gw = blockIdx.x * 8 + wave, NGW = G_ * 8;
    f32x4 gv[8];
#pragma unroll
    for (int j = 0; j < 4; ++j) { gv[2 * j] = *(const f32x4*)(fg + 8 * lane + 512 * j); gv[2 * j + 1] = *(const f32x4*)(fg + 8 * lane + 512 * j + 4); }
    for (int row = gw; row < NTOK; row += NGW) { const float rs = __builtin_amdgcn_rsqf(wave_sum(lane < 32 ? ss[(size_t)row * 32 + lane] : 0.f) * pg8::INV_D + pg8::RMS_EPS);
        const bf16* xr = xbf + (size_t)row * DM + 8 * lane; float* orow = out + (size_t)row * DM + 8 * lane;
#pragma unroll
        for (int j = 0; j < 4; ++j) { const u32x4 v = *(const u32x4*)(xr + 512 * j);
            f32x4 a = (f32x4){bf_lo(v[0]), bf_hi(v[0]), bf_lo(v[1]), bf_hi(v[1])}, b = (f32x4){bf_lo(v[2]), bf_hi(v[2]), bf_lo(v[3]), bf_hi(v[3])};
            *(f32x4*)(orow + 512 * j) = a * rs * gv[2 * j]; *(f32x4*)(orow + 512 * j + 4) = b * rs * gv[2 * j + 1]; } }
}

#define SITE_IDS() int tid = (wave0_ << 6) | pg8::lane_id_fresh(); asm volatile("" : "+v"(tid)); const int lane = tid & 63, wave = __builtin_amdgcn_readfirstlane(tid >> 6); (void)lane; (void)wave
struct SkipOrder : pg8::StaticOrder { __device__ bool next(int i, pg8::Unit& u) const { if (!pg8::StaticOrder::next(i, u)) return false; if (u.pn >= 16) u.pn += 2; return true; } };
struct PairOrder : pg8::StaticOrder { __device__ bool next(int i, pg8::Unit& u) const { if (!pg8::StaticOrder::next(i, u)) return false; u.pn += 16; return true; } };
struct HotOrder : pg8::StaticOrder { bool hot;
    __device__ bool next(int i, pg8::Unit& u) const { if (!pg8::StaticOrder::next(i, u)) return false; if (hot) { u.pm = c & 7; u.pn = (c >> 3) & 1; } return true; }
};
struct RangeOrder : pg8::StaticOrder { int lo, hi;
    __device__ bool next(int i, pg8::Unit& u) const { if (lo + i >= hi) return false; return pg8::StaticOrder::next(lo + i, u); }
};
#ifndef DUP_ATT
#define DUP_ATT 1
#endif
#ifndef DUP_ATT1
#define DUP_ATT1 1
#endif
#ifndef DUP_BAR
#define DUP_BAR 1
#endif
#ifndef DUP_MP
#define DUP_MP 1
#endif
#ifndef DUP_GU
#define DUP_GU 1
#endif
#ifndef DUP_IN
#define DUP_IN 1
#endif
#ifndef DUP_DN
#define DUP_DN 1
#endif
#ifndef DUP_OUT
#define DUP_OUT 1
#endif
#ifndef GP_ALIGN
#define GP_ALIGN true
#endif
#ifndef GP_ALIGN8
#define GP_ALIGN8 true
#endif
#ifndef GP_SP28
#define GP_SP28 true
#endif
#ifndef GP_SP2
#define GP_SP2 true
#endif
#ifndef WGM_GU
#define WGM_GU 4
#endif
#ifndef WGM_GU8
#define WGM_GU8 4
#endif
#ifndef WGM_IN8
#define WGM_IN8 6
#endif
#ifndef WGM_N2K
#define WGM_N2K 4
#endif
#ifndef ROT_IN8
#define ROT_IN8 1
#endif
#ifndef PMX_DN
#define PMX_DN 4
#endif
#ifndef PMX_OUT
#define PMX_OUT 0
#endif
#ifndef DUP_PRO
#define DUP_PRO 1
#endif
struct Args { Ptrs p; int lo, hi; };
__global__ void __launch_bounds__(512, 2) fwd(Args args) {
    extern __shared__ __attribute__((aligned(16))) unsigned char lds_raw[];
    LAS unsigned char* lds = (LAS unsigned char*)lds_raw;
    const int G = gridDim.x;
    const Ptrs& P = args.p;
    unsigned char* ws = P.ws;
    volatile LAS unsigned* MISC = (volatile LAS unsigned*)(lds + MISC_OFF);
    if (threadIdx.x < 16) MISC[threadIdx.x] = 0u;
    __syncthreads();
    XcdBarrier bar = xcd_barrier_post((unsigned*)(ws + WS_CTL) + CW_BAR, MISC + 8);
    const int wave0_ = (int)bar.wv;
    const int lo = args.lo, hi = args.hi;
    int step = 0;
#define RUN_STEP (step >= lo && step < hi)
#define END_STEP do { if (step >= lo && step + 1 < hi) { for (int rep_ = 0; rep_ < DUP_BAR; ++rep_) xcd_barrier(bar); } ++step; } while (0)
    float* SS = (float*)(ws + WS_SS);
    bf16* XB = (bf16*)(ws + WS_XB); bf16* HB = (bf16*)(ws + WS_H); bf16* OG = (bf16*)(ws + WS_OG); bf16* ZB = (bf16*)(ws + WS_Z); bf16* MIX = (bf16*)(ws + WS_MIX);
    float* LSE = (float*)(ws + WS_LSE);

    if (RUN_STEP) { SITE_IDS(); for (int rep = 0; rep < DUP_PRO; ++rep) prologue(P, lds, tid, lane, wave, G, 0); }
    END_STEP;

    for (int c = 0; c < NCHUNK; ++c) {
        const size_t r0 = (size_t)c * TC;
        bf16* xb = XB + r0 * DM;
        for (int i = 0; i < 2 * DEPTH; ++i) {
            const int l = i >> 1, j = i & 1;
            const unsigned char* wl = ws + WS_W + (size_t)l * W_LAYER;
            const bool gu8 = ((I8GU_MASK >> i) & 1u) != 0u;
            if (I8GU_MASK != 0u && gu8) {
                if (RUN_STEP) { SITE_IDS(); quant_rows<false>(xb, ws + WS_XB8 + r0 * DM, (float*)(ws + WS_SA) + r0, nullptr, SS + ((size_t)(3 * l + 2 * j) * NTOK + r0) * 32, lane, wave, G); }
                END_STEP;
                if (RUN_STEP) { pg8::Gemm g{(const bf16*)(ws + WS_XB8 + r0 * DM), (const bf16*)(wl + (j ? WO_GU1 : WO_GU0)), TC, NGU, DM}; pg8::StaticOrder S; S.init(TC, NGU, G, (int)blockIdx.x, WGM_GU8);
                    pg8::EpiSwiGLUI8 E{HB, DFF, (const float*)ws, (unsigned)(WS_SA + r0 * 4), (unsigned)(WS_CM + (size_t)(CM_GU + i * NGU) * 4)};
                    for (int rep = 0; rep < DUP_GU8; ++rep) pg8::gemm_phase<pg8::EpiSwiGLUI8, pg8::StaticOrder, GP_ALIGN8, GP_SP28, 3>(lds, g, S, E, wave0_); }
                END_STEP;
            } else {
            if (RUN_STEP) { pg8::Gemm g{xb, (const bf16*)(wl + (j ? WO_GU1 : WO_GU0)), TC, NGU, DM}; pg8::StaticOrder S; S.init(TC, NGU, G, (int)blockIdx.x, WGM_GU);
                pg8::EpiSwiGLU E{HB, DFF, SS + ((size_t)(3 * l + 2 * j) * NTOK + r0) * 32};
#if defined(HOT_GU)
                HotOrder S2; S2.init(TC, NGU, G, (int)blockIdx.x);
                for (int rep = 0; rep < 2; ++rep) { S2.hot = (rep == 0); pg8::EpiSwiGLU E2{rep == 0 ? (bf16*)(ws + WS_END) : HB, DFF, SS + ((size_t)(3 * l + 2 * j) * NTOK + r0) * 32};
                  pg8::gemm_phase<pg8::EpiSwiGLU, HotOrder, GP_ALIGN, GP_SP2>(lds, g, S2, E2, wave0_); }
#else
#if defined(PROBE_SPLIT)
                { RangeOrder S3; S3.init(TC, NGU, G, (int)blockIdx.x, WGM_GU); S3.lo = 0; S3.hi = 5; pg8::gemm_phase<pg8::EpiSwiGLU, RangeOrder, GP_ALIGN, GP_SP2>(lds, g, S3, E, wave0_);
                  xcd_barrier(bar);
                  S3.lo = 5; S3.hi = 11; pg8::gemm_phase<pg8::EpiSwiGLU, RangeOrder, GP_ALIGN, GP_SP2>(lds, g, S3, E, wave0_); }
#else
                for (int rep = 0; rep < DUP_GU; ++rep) pg8::gemm_phase<pg8::EpiSwiGLU, pg8::StaticOrder, GP_ALIGN, GP_SP2>(lds, g, S, E, wave0_);
#endif
#endif
                }
            END_STEP;
            }
            if (RUN_STEP) { pg8::Gemm g{HB, (const bf16*)(wl + (j ? WO_D1 : WO_D0)), TC, DM, DFF}; pg8::StaticOrder S; S.init(TC, DM, G, (int)blockIdx.x, WGM_N2K, 1, PMX_DN);
                pg8::EpiResidual E{xb, SS + ((size_t)(3 * l + 2 * j + 1) * NTOK + r0) * 32, 0.5f, nullptr, xb};
#if defined(PROBE_DN)
                for (int rep = 0; rep < 2; ++rep) { pg8::EpiResidual E2 = E; if (rep == 0) { E2.xw = (bf16*)(ws + WS_END); E2.ssn = SS + (size_t)13 * NTOK * 32; E2.x8 = nullptr; } pg8::gemm_phase<pg8::EpiResidual, pg8::StaticOrder, GP_ALIGN, GP_SP2>(lds, g, S, E2, wave0_); }
#else
                pg8::gemm_phase<pg8::EpiResidual, pg8::StaticOrder, false, GP_SP2>(lds, g, S, E, wave0_);
#endif
                }
            END_STEP;
            if (j == 0) {
                if (RUN_STEP) { SITE_IDS(); quant_rows<true>(xb, ws + WS_XB8 + r0 * DM, (float*)(ws + WS_SA) + r0, (float*)(ws + WS_SR) + r0, SS + ((size_t)(3 * l + 1) * NTOK + r0) * 32, lane, wave, G); }
                END_STEP;
                if (RUN_STEP) {
                    { constexpr int NIN8 = I8_POOLIN ? INW : QKVW;
                      pg8::Gemm g{(const bf16*)(ws + WS_XB8 + r0 * DM), (const bf16*)(wl + WO_IN), TC, NIN8, DM}; SkipOrder S; S.init(TC, NIN8 - 512, G, (int)blockIdx.x, WGM_IN8, ROT_IN8);
                      pg8::EpiScaleI8 E{ZB, INW, (const float*)ws, (unsigned)(WS_SA + r0 * 4), (unsigned)(WS_CM + (size_t)(CM_IN + l * INW) * 4), QSCALE, 1.0f};
                      for (int rep = 0; rep < DUP_IN8; ++rep) pg8::gemm_phase<pg8::EpiScaleI8, SkipOrder, GP_ALIGN8, GP_SP28, 3>(lds, g, S, E, wave0_); }
                    }
                END_STEP;
                if (RUN_STEP) {
                    { pg8::Gemm g{(const bf16*)(ws + WS_XB8 + r0 * DM), (const bf16*)(wl + WO_IN), TC, QKVW, DM}; PairOrder S; S.init(TC, 512, G, (int)blockIdx.x, 4, 0);
                      pg8::EpiScaleI8 E{ZB, INW, (const float*)ws, (unsigned)(WS_SA + r0 * 4), (unsigned)(WS_CM + (size_t)(CM_IN + l * INW) * 4), QSCALE, 1.0f};
                      pg8::gemm_phase<pg8::EpiScaleI8, PairOrder, GP_ALIGN8, GP_SP28, 3>(lds, g, S, E, wave0_); }
                    if (!I8_POOLIN) { pg8::Gemm g{xb, (const bf16*)(wl + WO_INU), TC, POOLW, DM}; pg8::StaticOrder S; S.init(TC, POOLW, G, ((int)blockIdx.x + G / 2) % G);
                      pg8::EpiScaleBf16 E{ZB + QKVW, INW, (const float*)(ws + WS_SR) + r0, 1.0f, 1.0f, 0};
                      pg8::gemm_phase<pg8::EpiScaleBf16, pg8::StaticOrder, GP_ALIGN, GP_SP2, 2>(lds, g, S, E, wave0_); }
                    SITE_IDS(); const int n0 = G - G / 2, n1 = G / 2, bx = (int)blockIdx.x; const bool up = bx >= n0;
                    const int ci = (G % 16 == 0) ? (bx % 8) * (G / 16) + (bx / 8) % (G / 16) : (up ? bx - n0 : bx);
                    for (int rep = 0; rep < DUP_ATT; ++rep) attn_phase<0>(ZB, OG, LSE, MIX, (const float*)(ws + WS_LUT), lds, tid, lane, wave, up ? ATT_SPLIT + ci : ci, up ? n1 : n0, up ? 2304 : ATT_SPLIT); }
                END_STEP;
                if (RUN_STEP) { SITE_IDS(); const int vcu = (G % 8 == 0) ? ((int)blockIdx.x % 8) * (G / 8) + (int)blockIdx.x / 8 : (int)blockIdx.x;
                    for (int rep = 0; rep < DUP_ATT1; ++rep) attn_phase<1>(ZB, OG, LSE, MIX, (const float*)(ws + WS_LUT), lds, tid, lane, wave, vcu, G, 768); }
                if (RUN_STEP) { SITE_IDS();
                    for (int rep = 0; rep < DUP_MP; ++rep) pool_phase(ZB, MIX, (const bf16*)(ws + WS_WPT) + (size_t)l * 4 * 16384, P.pool_scale + l * POOLW, lane, wave, G); }
                END_STEP;
                if (RUN_STEP) { pg8::Gemm g{MIX, (const bf16*)(wl + WO_OUT), TC, DM, DM}; pg8::StaticOrder S; S.init(TC, DM, G, (int)blockIdx.x, WGM_N2K, 1, PMX_OUT);
                    pg8::EpiResidual E{xb, SS + ((size_t)(3 * l + 2) * NTOK + r0) * 32, 1.0f, nullptr, xb};
#if defined(PROBE_OUT)
                    for (int rep = 0; rep < 2; ++rep) { pg8::EpiResidual E2 = E; if (rep == 0) { E2.xw = (bf16*)(ws + WS_END); E2.ssn = SS + (size_t)13 * NTOK * 32; } pg8::gemm_phase<pg8::EpiResidual, pg8::StaticOrder, GP_ALIGN, GP_SP2>(lds, g, S, E2, wave0_); }
#else
                    pg8::gemm_phase<pg8::EpiResidual, pg8::StaticOrder, false, GP_SP2>(lds, g, S, E, wave0_);
#endif
                    }
                END_STEP;
            }
        }
    }
    if (RUN_STEP) { SITE_IDS(); final_norm(P.out, XB, SS + (size_t)12 * NTOK * 32, P.final_g, lane, wave, G); }
    END_STEP;
#undef RUN_STEP
#undef END_STEP
}

#ifndef MK_MULTI
#define MK_MULTI 0
#endif
extern "C" void kernel_launch(void* const* d_in, const int* in_sizes, int n_in, void* d_out, int out_size, void* d_ws, size_t ws_size, hipStream_t stream) {
    static int grid = 0;
    if (grid == 0) {
        if (n_in != 12 || out_size != NTOK * DM || ws_size < WS_END) { fprintf(stderr, "kernel_launch: unexpected problem (n_in %d, out %d, ws %zu)\n", n_in, out_size, ws_size); grid = -1; return; }
        int dev = 0, cus = 0, per_cu = 0;
        if (hipGetDevice(&dev) != hipSuccess || hipDeviceGetAttribute(&cus, hipDeviceAttributeMultiprocessorCount, dev) != hipSuccess) { grid = -1; return; }
        if (hipFuncSetAttribute((const void*)fwd, hipFuncAttributeMaxDynamicSharedMemorySize, LDS_BYTES) != hipSuccess) { fprintf(stderr, "kernel_launch: hipFuncSetAttribute failed\n"); grid = -1; return; }
        if (hipOccupancyMaxActiveBlocksPerMultiprocessor(&per_cu, (const void*)fwd, 512, LDS_BYTES) != hipSuccess || per_cu < 1) { fprintf(stderr, "kernel_launch: occupancy query says %d\n", per_cu); }
        (void)hipGetLastError();
        grid = cus;
    }
    if (grid < 0) return;
    (void)hipMemsetAsync((char*)d_ws + WS_CTL, 0, CTL_ZERO_BYTES, stream);
    Args a{};
    a.p.x_prompt = (const float*)d_in[0]; a.p.x_sample = (const float*)d_in[1]; a.p.norm_g = (const float*)d_in[2]; a.p.ffn_gate = (const float*)d_in[3];
    a.p.ffn_up = (const float*)d_in[4]; a.p.ffn_down = (const float*)d_in[5]; a.p.w_in = (const float*)d_in[6]; a.p.w_pool = (const float*)d_in[7];
    a.p.pool_scale = (const float*)d_in[8]; a.p.w_out = (const float*)d_in[9]; a.p.rel_bias = (const float*)d_in[10]; a.p.final_g = (const float*)d_in[11];
    a.p.out = (float*)d_out; a.p.ws = (unsigned char*)d_ws;
#if MK_MULTI
    for (int s = 0; s < NSTEPS; ++s) { a.lo = s; a.hi = s + 1; hipLaunchKernelGGL(fwd, dim3(grid), dim3(512), LDS_BYTES, stream, a); }
#else
    a.lo = 0; a.hi = 1 << 30;
    hipLaunchKernelGGL(fwd, dim3(grid), dim3(512), LDS_BYTES, stream, a);
#endif
}
```

```cpp
#include <hip/hip_runtime.h>
#include <cstdio>
#include <cstdint>
namespace pg8 {
#define PG8_LAS __attribute__((address_space(3)))
typedef unsigned short bf16_t;
typedef short bf16x8 __attribute__((ext_vector_type(8)));
typedef float f32x4 __attribute__((ext_vector_type(4)));
typedef unsigned u32x4 __attribute__((ext_vector_type(4)));
typedef int i32x8 __attribute__((ext_vector_type(8)));
typedef int i32x4_ __attribute__((ext_vector_type(4)));
constexpr int BM = 256, BK = 64, HALF = 128, HTB = HALF * BK * 2  , STAGE_BYTES = 8 * HTB, NXCD = 8;

__host__ __device__ __forceinline__ int lds_byte(int r, int c) { const int st = (r >> 4) * 2 + (c >> 5), rr = r & 15, cc = c & 31, ob = rr * 64 + cc * 2; return st * 1024 + (ob ^ (((ob >> 9) & 1) << 5)); }
__host__ __device__ __forceinline__ void stage_rc(int b, int& R, int& C) { const int st = b / 1024, sb = b % 1024, swz = sb ^ (((sb >> 9) & 1) << 5); R = (st >> 1) * 16 + swz / 64; C = (st & 1) * 32 + (swz % 64) / 2; }
__host__ __device__ __forceinline__ int perm32(int rho) { const int n = rho >> 4, i = rho & 15; return 8 * (i >> 2) + 4 * n + (i & 3); }

#ifndef PG8_B_BLOCKED
#define PG8_B_BLOCKED 1
#endif
__host__ __device__ __forceinline__ int inv_perm32(int w) { return 16 * ((w >> 2) & 1) + (((w >> 3) << 2) | (w & 3)); }
__host__ __device__ __forceinline__ size_t bblk_off(int n, int kbyte, int Kb) {
    const int slot = (n & ~31) + inv_perm32(n & 31), ob = (slot & 15) * 64 + (kbyte & 63);
    return ((size_t)(slot >> 4) * (size_t)(Kb >> 6) + (size_t)(kbyte >> 6)) * 1024 + (size_t)(ob ^ (((ob >> 9) & 1) << 5)); }
__device__ __forceinline__ int lane_id_fresh() { int l_; asm volatile("v_mbcnt_lo_u32_b32 %0, -1, 0\n\tv_mbcnt_hi_u32_b32 %0, -1, %0" : "=v"(l_)); return l_; }
struct Unit { int pm, pn; };
struct Gemm { const bf16_t* A; const bf16_t* Bt; int M, N, K; };

struct StaticOrder {
    int nM, nN, nwg, G, c, WGM, rot, pmx;
    __host__ __device__ void init(int M, int N, int G_, int c_, int wgm = 4, int rot_ = 1, int pmx_ = 0) { nM = M / BM; nN = N / BM; nwg = nM * nN; G = G_; c = c_; WGM = wgm; rot = rot_; pmx = pmx_; }
    __host__ __device__ bool next(int i, Unit& u) const {
        const long L = (long)i * G + c; if (L >= nwg) return false;
        int wgid = (int)L; { const int q = nwg / NXCD, r = nwg % NXCD, xcd = wgid % NXCD, off = wgid / NXCD; wgid = (xcd < r ? xcd * (q + 1) : r * (q + 1) + (xcd - r) * q) + off; }
        const int nig = WGM * nN, gid = wgid / nig, fm = gid * WGM, gsz = (nM - fm) < WGM ? (nM - fm) : WGM;
        u.pm = fm + ((wgid % nig) % gsz); u.pn = (wgid % nig) / gsz;
        if (rot) u.pn = (u.pn + (u.pm >> 3) * (nN / NXCD)) % nN;
        u.pm ^= pmx; return true;
    }
    __device__ __forceinline__ void a_ready(const Unit&) const {}
    __device__ __forceinline__ void done(const Unit&) const {}
};
__device__ __forceinline__ unsigned cvt_pk_bf16(float lo, float hi) { unsigned r; asm volatile("v_cvt_pk_bf16_f32 %0, %1, %2" : "=v"(r) : "v"(lo), "v"(hi)); return r; }
typedef float f32x2 __attribute__((ext_vector_type(2)));
typedef unsigned u32x2_ __attribute__((ext_vector_type(2)));
constexpr float RMS_EPS = 1e-6f;
constexpr float INV_D = 1.0f / 2048.0f;
__device__ __forceinline__ float row_rstd(const float* ssp, int row, int fq) {
    const f32x4 a = *(const f32x4*)(ssp + (size_t)row * 32 + 8 * fq), b = *(const f32x4*)(ssp + (size_t)row * 32 + 8 * fq + 4);
    float s = ((a[0] + a[1]) + (a[2] + a[3])) + ((b[0] + b[1]) + (b[2] + b[3]));
    s += __shfl_xor(s, 16); s += __shfl_xor(s, 32);
    return __builtin_amdgcn_rsqf(s * INV_D + RMS_EPS);
}
__device__ __forceinline__ float row_msq(const float* ssp, int row, int fq) {
    const f32x4 a = *(const f32x4*)(ssp + (size_t)row * 32 + 8 * fq), b = *(const f32x4*)(ssp + (size_t)row * 32 + 8 * fq + 4);
    float s = ((a[0] + a[1]) + (a[2] + a[3])) + ((b[0] + b[1]) + (b[2] + b[3]));
    s += __shfl_xor(s, 16); s += __shfl_xor(s, 32);
    return s * INV_D + RMS_EPS;
}
struct EpiSwiGLU {
    static constexpr bool PERM = true, AFTER_DRAIN = false, LDS_SCALES = false;
    bf16_t* H; int ldh; const float* ss;
    __device__ __forceinline__ void operator()(const f32x4 (&acc)[2][2][4][2], const Unit& u, int wr, int wc, int fr, int fq) const {
        const int row0 = u.pm * BM + wr * 64 + fr, col0 = u.pn * HALF + wc * 32 + 8 * fq;
#ifdef DUP_EPI
        for (int rep_ = 0; rep_ < DUP_EPI; ++rep_)
#endif
#pragma unroll
        for (int ai = 0; ai < 2; ++ai)
#pragma unroll
            for (int m = 0; m < 4; ++m) { const int row = row0 + ai * HALF + m * 16; const float v = row_msq(ss, row, fq), c1 = -1.4426950408889634f * __builtin_amdgcn_rsqf(v);
                const f32x2 vv = (f32x2){v, v}, cc = (f32x2){c1, c1};
                unsigned w[4]; f32x2 g[4], up[4], e[4], r[4];
#pragma unroll
                for (int q = 0; q < 4; ++q) { g[q] = (f32x2){acc[ai][0][m][q >> 1][2 * (q & 1)], acc[ai][0][m][q >> 1][2 * (q & 1) + 1]}; up[q] = (f32x2){acc[ai][1][m][q >> 1][2 * (q & 1)], acc[ai][1][m][q >> 1][2 * (q & 1) + 1]}; }
#pragma unroll
                for (int q = 0; q < 4; ++q) { const f32x2 ea = g[q] * cc; e[q].x = __builtin_amdgcn_exp2f(ea.x); e[q].y = __builtin_amdgcn_exp2f(ea.y); }
#pragma unroll
                for (int q = 0; q < 4; ++q) { const f32x2 den = e[q] * vv + vv; r[q].x = __builtin_amdgcn_rcpf(den.x); r[q].y = __builtin_amdgcn_rcpf(den.y); }
#pragma unroll
                for (int q = 0; q < 4; ++q) { const f32x2 hv = (g[q] * up[q]) * r[q]; w[q] = cvt_pk_bf16(hv.x, hv.y); }
                u32x4 o; o.x = w[0]; o.y = w[1]; o.z = w[2]; o.w = w[3];
                *(u32x4*)(H + (size_t)row * ldh + col0) = o; }
    }
};
struct EpiScaleBf16 {
    static constexpr bool PERM = true, AFTER_DRAIN = false, LDS_SCALES = false;
    bf16_t* Z; int ldz; const float* rsd; float csq, cso; int qtiles;
    __device__ __forceinline__ void operator()(const f32x4 (&acc)[2][2][4][2], const Unit& u, int wr, int wc, int fr, int fq) const {
        const int row0 = u.pm * BM + wr * 64 + fr, col0 = u.pn * BM + wc * 32 + 8 * fq;
        const float cs = (qtiles && (u.pn % 18) < 6) ? csq : cso;
#pragma unroll
        for (int ai = 0; ai < 2; ++ai)
#pragma unroll
            for (int m = 0; m < 4; ++m) { const int row = row0 + ai * HALF + m * 16; const float rs = rsd[row] * cs;
#pragma unroll
                for (int bj = 0; bj < 2; ++bj) { const f32x4 v0 = acc[ai][bj][m][0] * rs, v1 = acc[ai][bj][m][1] * rs;
                    u32x4 o; o.x = cvt_pk_bf16(v0[0], v0[1]); o.y = cvt_pk_bf16(v0[2], v0[3]); o.z = cvt_pk_bf16(v1[0], v1[1]); o.w = cvt_pk_bf16(v1[2], v1[3]);
                    *(u32x4*)(Z + (size_t)row * ldz + col0 + bj * HALF) = o; } }
    }
};
__device__ __forceinline__ f32x4 i2f4(f32x4 a) { const i32x4_ i = __builtin_bit_cast(i32x4_, a); return (f32x4){(float)i[0], (float)i[1], (float)i[2], (float)i[3]}; }
struct EpiScaleI8 {
    static constexpr bool PERM = true, AFTER_DRAIN = false, LDS_SCALES = true;
    bf16_t* Z; int ldz; const float* sbase; unsigned row_off, col_off; float csq, cso;
    __device__ __forceinline__ void operator()(const f32x4 (&acc)[2][2][4][2], const Unit& u, int wr, int wc, int fr, int fq, const PG8_LAS float* lsc) const {
        const int row0 = u.pm * BM + wr * 64 + fr, col0 = u.pn * BM + wc * 32 + 8 * fq;
        const float cs = ((u.pn < 54 && (u.pn % 18) < 6) ? csq : cso) * (1.0f / 127.0f);
        f32x4 cb[2][2];
#pragma unroll
        for (int bj = 0; bj < 2; ++bj)
#pragma unroll
            for (int n = 0; n < 2; ++n) cb[bj][n] = *(const PG8_LAS f32x4*)(lsc + 256 + wc * 32 + 8 * fq + bj * HALF + 4 * n) * cs;
#pragma unroll
        for (int ai = 0; ai < 2; ++ai)
#pragma unroll
            for (int m = 0; m < 4; ++m) { const int row = row0 + ai * HALF + m * 16; const float rs = lsc[ai * HALF + wr * 64 + m * 16 + fr];
#pragma unroll
                for (int bj = 0; bj < 2; ++bj) { const f32x4 v0 = i2f4(acc[ai][bj][m][0]) * cb[bj][0] * rs, v1 = i2f4(acc[ai][bj][m][1]) * cb[bj][1] * rs;
                    u32x4 o; o.x = cvt_pk_bf16(v0[0], v0[1]); o.y = cvt_pk_bf16(v0[2], v0[3]); o.z = cvt_pk_bf16(v1[0], v1[1]); o.w = cvt_pk_bf16(v1[2], v1[3]);
                    *(u32x4*)(Z + (size_t)row * ldz + col0 + bj * HALF) = o; } }
    }
};
struct EpiSwiGLUI8 {
    static constexpr bool PERM = true, AFTER_DRAIN = false, LDS_SCALES = true;
    bf16_t* H; int ldh; const float* sbase; unsigned row_off, col_off;
    __device__ __forceinline__ void operator()(const f32x4 (&acc)[2][2][4][2], const Unit& u, int wr, int wc, int fr, int fq, const PG8_LAS float* lsc) const {
        const int row0 = u.pm * BM + wr * 64 + fr, col0 = u.pn * HALF + wc * 32 + 8 * fq;
        f32x2 cg[4], cu[4];
        { const PG8_LAS float* lc = lsc + 256 + wc * 32 + 8 * fq;
          const f32x4 g0 = *(const PG8_LAS f32x4*)(lc), g1 = *(const PG8_LAS f32x4*)(lc + 4), u0 = *(const PG8_LAS f32x4*)(lc + HALF), u1 = *(const PG8_LAS f32x4*)(lc + HALF + 4);
          cg[0] = (f32x2){g0[0], g0[1]} * (1.0f / 127.0f); cg[1] = (f32x2){g0[2], g0[3]} * (1.0f / 127.0f); cg[2] = (f32x2){g1[0], g1[1]} * (1.0f / 127.0f); cg[3] = (f32x2){g1[2], g1[3]} * (1.0f / 127.0f);
          cu[0] = (f32x2){u0[0], u0[1]} * (1.0f / 127.0f); cu[1] = (f32x2){u0[2], u0[3]} * (1.0f / 127.0f); cu[2] = (f32x2){u1[0], u1[1]} * (1.0f / 127.0f); cu[3] = (f32x2){u1[2], u1[3]} * (1.0f / 127.0f); }
#pragma unroll
        for (int ai = 0; ai < 2; ++ai)
#pragma unroll
            for (int m = 0; m < 4; ++m) { const int row = row0 + ai * HALF + m * 16; const float a = lsc[ai * HALF + wr * 64 + m * 16 + fr];
                const f32x2 aa = (f32x2){a, a}, ae = (f32x2){a * -1.4426950408889634f, a * -1.4426950408889634f};
                unsigned w[4]; f32x2 gf[4], uf[4], G[4], e[4], r[4];
#pragma unroll
                for (int q = 0; q < 4; ++q) { const i32x4_ gi = __builtin_bit_cast(i32x4_, acc[ai][0][m][q >> 1]), ui = __builtin_bit_cast(i32x4_, acc[ai][1][m][q >> 1]);
                    gf[q] = (f32x2){(float)gi[2 * (q & 1)], (float)gi[2 * (q & 1) + 1]} * cg[q]; uf[q] = (f32x2){(float)ui[2 * (q & 1)], (float)ui[2 * (q & 1) + 1]} * cu[q]; }
#pragma unroll
                for (int q = 0; q < 4; ++q) { const f32x2 ea = gf[q] * ae; e[q].x = __builtin_amdgcn_exp2f(ea.x); e[q].y = __builtin_amdgcn_exp2f(ea.y); G[q] = gf[q] * aa; }
#pragma unroll
                for (int q = 0; q < 4; ++q) { const f32x2 den = e[q] + 1.0f; r[q].x = __builtin_amdgcn_rcpf(den.x); r[q].y = __builtin_amdgcn_rcpf(den.y); }
#pragma unroll
                for (int q = 0; q < 4; ++q) { const f32x2 hv = (G[q] * (uf[q] * aa)) * r[q]; w[q] = cvt_pk_bf16(hv.x, hv.y); }
                u32x4 o; o.x = w[0]; o.y = w[1]; o.z = w[2]; o.w = w[3];
                *(u32x4*)(H + (size_t)row * ldh + col0) = o; }
    }
};
struct EpiResidual {
    static constexpr bool PERM = true, AFTER_DRAIN = false, LDS_SCALES = false;
    bf16_t* xb; float* ssn; float sc; unsigned char* x8; bf16_t* xw;
    __device__ __forceinline__ void operator()(const f32x4 (&acc)[2][2][4][2], const Unit& u, int wr, int wc, int fr, int fq) const {
        const int row0 = u.pm * BM + wr * 64 + fr, col0 = u.pn * BM + wc * 32 + 8 * fq;
        u32x4 xa[2][4][2];
#pragma unroll
        for (int ai = 0; ai < 2; ++ai)
#pragma unroll
            for (int m = 0; m < 4; ++m) { const size_t off = (size_t)(row0 + ai * HALF + m * 16) * 2048 + col0;
#pragma unroll
                for (int bj = 0; bj < 2; ++bj) xa[ai][m][bj] = *(const u32x4*)(xb + off + bj * HALF); }
        asm volatile("" ::: "memory");
#pragma unroll
        for (int ai = 0; ai < 2; ++ai) {
            float qq[4];
#pragma unroll
            for (int m = 0; m < 4; ++m) { const int row = row0 + ai * HALF + m * 16; const size_t off = (size_t)row * 2048 + col0; float q = 0.f;
#pragma unroll
                for (int bj = 0; bj < 2; ++bj) { const u32x4 xo = xa[ai][m][bj]; const f32x4 d0 = acc[ai][bj][m][0] * sc, d1 = acc[ai][bj][m][1] * sc;
                    const float a0 = __uint_as_float(xo[0] << 16) + d0[0], a1 = __uint_as_float(xo[0] & 0xffff0000u) + d0[1], a2 = __uint_as_float(xo[1] << 16) + d0[2], a3 = __uint_as_float(xo[1] & 0xffff0000u) + d0[3];
                    const float b0 = __uint_as_float(xo[2] << 16) + d1[0], b1 = __uint_as_float(xo[2] & 0xffff0000u) + d1[1], b2 = __uint_as_float(xo[3] << 16) + d1[2], b3 = __uint_as_float(xo[3] & 0xffff0000u) + d1[3];
                    u32x4 o; o.x = cvt_pk_bf16(a0, a1); o.y = cvt_pk_bf16(a2, a3); o.z = cvt_pk_bf16(b0, b1); o.w = cvt_pk_bf16(b2, b3);
                    *(u32x4*)(xw + off + bj * HALF) = o;
                    if (x8) { u32x2_ e; e.x = __builtin_amdgcn_cvt_pk_fp8_f32(a0, a1, 0, false); e.x = __builtin_amdgcn_cvt_pk_fp8_f32(a2, a3, e.x, true);
                        e.y = __builtin_amdgcn_cvt_pk_fp8_f32(b0, b1, 0, false); e.y = __builtin_amdgcn_cvt_pk_fp8_f32(b2, b3, e.y, true); *(u32x2_*)(x8 + off + bj * HALF) = e; }
                    q += (a0 * a0 + a1 * a1) + (a2 * a2 + a3 * a3) + (b0 * b0 + b1 * b1) + (b2 * b2 + b3 * b3); }
                q += __shfl_xor(q, 16); q += __shfl_xor(q, 32); qq[m] = q; }
            { const float qs = (fq == 0) ? qq[0] : (fq == 1) ? qq[1] : (fq == 2) ? qq[2] : qq[3];
              ssn[(size_t)(row0 + ai * HALF + fq * 16) * 32 + u.pn * 4 + wc] = qs; }
            asm volatile("" ::: "memory"); }
    }
};
template <class Epi, class Sched, bool ALIGN_EPI = false, bool SP2 = false, int ESZ = 2>
__device__ __forceinline__ void gemm_phase(PG8_LAS unsigned char* lds, const Gemm g, const Sched& S, const Epi& E, int wv  ) {
    constexpr bool B_BLOCKED = (PG8_B_BLOCKED != 0) && Epi::PERM;
    int tid_ = (wv << 6) | lane_id_fresh(); asm volatile("" : "+v"(tid_));
    const int tid = tid_, wid = __builtin_amdgcn_readfirstlane(tid >> 6), lane = tid & 63, wr = wid >> 2, wc = wid & 3, fr = lane & 15, fq = lane >> 4;
    const int K = g.K, Kb = K * (ESZ == 2 ? 2 : 1)  , nt = Kb / (BK * 2);
    unsigned voffA[2], voffB[2];
#pragma unroll
    for (int i = 0; i < 2; ++i) { int R, C; stage_rc(tid * 16 + i * 8192, R, C); const int Rb = Epi::PERM ? ((R & ~31) + perm32(R & 31)) : R;
        voffA[i] = (unsigned)(R * Kb + C * 2);
        if constexpr (B_BLOCKED) { const int b_ = tid * 16 + i * 8192, st_ = b_ >> 10; (void)Rb; voffB[i] = (unsigned)(((st_ >> 1) * (Kb >> 6) + (st_ & 1)) * 1024 + (b_ & 1023)); }
        else voffB[i] = (unsigned)(Rb * Kb + C * 2); }
    const unsigned kstep = (unsigned)(BK * 2);
    const unsigned kstepB = B_BLOCKED ? 2048u : kstep;
    const unsigned hstep = (unsigned)HALF * (unsigned)Kb;
    const unsigned tstep = 2u * hstep;
    const unsigned ldsw = (unsigned)wid * 1024u;
    const int aoff = lds_byte(wr * 64 + fr, fq * 8), boff = lds_byte(wc * 32 + fr, fq * 8);
#define PG8_SA(b, h) (((b) * 2 + (h)) * HTB)
#define PG8_SB(b, h) ((4 + (b) * 2 + (h)) * HTB)
#define PG8_STAGE(bufoff, rsrc, soff, voff) do { _Pragma("unroll") for (int _i = 0; _i < 2; ++_i) \
        __builtin_amdgcn_raw_ptr_buffer_load_lds((rsrc), (PG8_LAS void*)(lds + (bufoff) + ldsw + _i * 8192), 16, (int)(voff)[_i], (int)(soff), 0, 0); } while (0)
#define PG8_LDA(dst, b, h) do { _Pragma("unroll") for (int m = 0; m < 4; ++m) _Pragma("unroll") for (int k = 0; k < 2; ++k) dst[m][k] = *(const PG8_LAS bf16x8*)(lds + PG8_SA(b, h) + aoff + m * 2048 + k * 1024); } while (0)
#define PG8_LDB(dst, b, h) do { _Pragma("unroll") for (int n = 0; n < 2; ++n) _Pragma("unroll") for (int k = 0; k < 2; ++k) dst[n][k] = *(const PG8_LAS bf16x8*)(lds + PG8_SB(b, h) + boff + n * 2048 + k * 1024); } while (0)
#define PG8_MMA(ai, bj, At, Bt) do { __builtin_amdgcn_s_setprio(1); \
        if constexpr (ESZ == 2) { _Pragma("unroll") for (int m = 0; m < 4; ++m) _Pragma("unroll") for (int n = 0; n < 2; ++n) _Pragma("unroll") for (int k = 0; k < 2; ++k) \
            acc[ai][bj][m][n] = __builtin_amdgcn_mfma_f32_16x16x32_bf16(Bt[n][k], At[m][k], acc[ai][bj][m][n], 0, 0, 0); } \
        else if constexpr (ESZ == 3) { _Pragma("unroll") for (int m = 0; m < 4; ++m) _Pragma("unroll") for (int n = 0; n < 2; ++n) _Pragma("unroll") for (int k = 0; k < 2; ++k) \
            acc[ai][bj][m][n] = __builtin_bit_cast(f32x4, __builtin_amdgcn_mfma_i32_16x16x64_i8(__builtin_bit_cast(i32x4_, Bt[n][k]), __builtin_bit_cast(i32x4_, At[m][k]), __builtin_bit_cast(i32x4_, acc[ai][bj][m][n]), 0, 0, 0)); } \
        else { _Pragma("unroll") for (int m = 0; m < 4; ++m) _Pragma("unroll") for (int n = 0; n < 2; ++n) { \
            const i32x8 b8_ = __builtin_shufflevector(__builtin_bit_cast(i32x4_, Bt[n][0]), __builtin_bit_cast(i32x4_, Bt[n][1]), 0, 1, 2, 3, 4, 5, 6, 7); \
            const i32x8 a8_ = __builtin_shufflevector(__builtin_bit_cast(i32x4_, At[m][0]), __builtin_bit_cast(i32x4_, At[m][1]), 0, 1, 2, 3, 4, 5, 6, 7); \
            asm volatile("v_mfma_scale_f32_16x16x128_f8f6f4 %0, %1, %2, %0, %3, %3 op_sel_hi:[0,0,0]" : "+v"(acc[ai][bj][m][n]) : "v"(b8_), "v"(a8_), "v"(one8_)); } } \
        __builtin_amdgcn_s_setprio(0); } while (0)
#define PG8_WAIT_V(n) asm volatile("s_waitcnt vmcnt(" #n ")" ::: "memory")
#define PG8_WAIT_L(n) asm volatile("s_waitcnt lgkmcnt(" #n ")" ::: "memory")
#define PG8_BAR __builtin_amdgcn_s_barrier()
#define PG8_SCHED __builtin_amdgcn_sched_barrier(0)
    const int one8_ = 0x7f7f7f7f;
    Unit cur, nxt; int ui = 0;
    if (!S.next(0, cur)) return;
    f32x4 acc[2][2][4][2];
#pragma unroll
    for (int a = 0; a < 2; ++a)
#pragma unroll
        for (int b = 0; b < 2; ++b)
#pragma unroll
            for (int m = 0; m < 4; ++m)
#pragma unroll
                for (int n = 0; n < 2; ++n) { typedef double f64x2_ __attribute__((ext_vector_type(2))); f64x2_ z_; asm volatile("v_mov_b64 %0, 0" : "=v"(z_.x)); asm volatile("v_mov_b64 %0, 0" : "=v"(z_.y)); acc[a][b][m][n] = __builtin_bit_cast(f32x4, z_); }
    bf16x8 At[4][2], B0[2][2], B1[2][2];
    const __amdgpu_buffer_rsrc_t rA = __builtin_amdgcn_make_buffer_rsrc((void*)g.A, 0, (int)((unsigned)g.M * (unsigned)Kb), 0x00020000), rB = __builtin_amdgcn_make_buffer_rsrc((void*)g.Bt, 0, (int)((unsigned)g.N * (unsigned)Kb), 0x00020000);
    unsigned cA = (unsigned)cur.pm * tstep, cB = (unsigned)cur.pn * tstep;
    __amdgpu_buffer_rsrc_t rS = rA; unsigned voffS = 0;
    if constexpr (Epi::LDS_SCALES) { rS = __builtin_amdgcn_make_buffer_rsrc((void*)E.sbase, 0, 1 << 24, 0x00020000); voffS = (unsigned)(lane * 4 + (wid & 3) * 256); }
    S.a_ready(cur);
    if constexpr (SP2) {
        PG8_STAGE(PG8_SB(0, 0), rB, cB, voffB); PG8_STAGE(PG8_SB(0, 1), rB, cB + hstep, voffB); PG8_STAGE(PG8_SA(0, 0), rA, cA, voffA); PG8_STAGE(PG8_SA(0, 1), rA, cA + hstep, voffA);
        if (wr == 1) PG8_BAR;
        PG8_WAIT_V(2); PG8_BAR;
        PG8_STAGE(PG8_SB(1, 0), rB, cB + kstepB, voffB); PG8_STAGE(PG8_SA(1, 0), rA, cA + kstep, voffA); PG8_STAGE(PG8_SB(1, 1), rB, cB + hstep + kstepB, voffB);
        PG8_WAIT_V(6); PG8_BAR;
    } else {
        PG8_STAGE(PG8_SB(0, 0), rB, cB, voffB); PG8_STAGE(PG8_SA(0, 0), rA, cA, voffA); PG8_STAGE(PG8_SB(0, 1), rB, cB + hstep, voffB); PG8_STAGE(PG8_SA(0, 1), rA, cA + hstep, voffA);
        if (wr == 1) PG8_BAR;
        PG8_WAIT_V(4); PG8_BAR;
        PG8_STAGE(PG8_SB(1, 0), rB, cB + kstepB, voffB); PG8_STAGE(PG8_SA(1, 0), rA, cA + kstep, voffA); PG8_STAGE(PG8_SB(1, 1), rB, cB + hstep + kstepB, voffB);
        PG8_WAIT_V(6); PG8_BAR;
    }
    for (;;) {
        const bool has_next = S.next(ui + 1, nxt);
        const unsigned nA = has_next ? (unsigned)nxt.pm * tstep : cA, nB = has_next ? (unsigned)nxt.pn * tstep : cB;
        for (int t = 0; t < nt; t += 2) {
            const bool last = (t == nt - 2);
            const unsigned a1 = cA + (unsigned)(t + 1) * kstep;
            const unsigned a2 = last ? nA : cA + (unsigned)(t + 2) * kstep, b2 = last ? nB : cB + (unsigned)(t + 2) * kstepB;
            const unsigned a3 = a2 + kstep, b3 = b2 + kstepB;
            if (last && has_next) S.a_ready(nxt);
            if constexpr (Epi::LDS_SCALES) { if (last) {
                const unsigned so_ = (wid < 4) ? E.row_off + (unsigned)cur.pm * 1024u : E.col_off + (unsigned)cur.pn * 1024u;
                __builtin_amdgcn_raw_ptr_buffer_load_lds(rS, (PG8_LAS void*)(lds + 131072 + wid * 256), 4, (int)voffS, (int)so_, 0, 0); } }
            if constexpr (SP2) {
            PG8_LDB(B0, 0, 0); PG8_LDB(B1, 0, 1); PG8_SCHED; PG8_LDA(At, 0, 0); PG8_STAGE(PG8_SA(1, 1), rA, a1 + hstep, voffA);
            PG8_WAIT_V(8); PG8_WAIT_L(0); PG8_BAR; PG8_MMA(0, 0, At, B0); PG8_MMA(0, 1, At, B1); PG8_BAR; PG8_SCHED;
            PG8_LDA(At, 0, 1); PG8_STAGE(PG8_SB(0, 0), rB, b2, voffB); PG8_STAGE(PG8_SB(0, 1), rB, b2 + hstep, voffB); PG8_STAGE(PG8_SA(0, 0), rA, a2, voffA);
            PG8_WAIT_V(8); PG8_WAIT_L(0); PG8_BAR; PG8_MMA(1, 0, At, B0); PG8_MMA(1, 1, At, B1); PG8_BAR; PG8_SCHED;
            PG8_LDB(B0, 1, 0); PG8_LDB(B1, 1, 1); PG8_SCHED; PG8_LDA(At, 1, 0); PG8_STAGE(PG8_SA(0, 1), rA, a2 + hstep, voffA);
            PG8_WAIT_V(8); PG8_WAIT_L(0); PG8_BAR; PG8_MMA(0, 0, At, B0); PG8_MMA(0, 1, At, B1); PG8_BAR; PG8_SCHED;
            PG8_LDA(At, 1, 1); PG8_STAGE(PG8_SB(1, 0), rB, b3, voffB); PG8_STAGE(PG8_SB(1, 1), rB, b3 + hstep, voffB); PG8_STAGE(PG8_SA(1, 0), rA, a3, voffA);
            PG8_WAIT_V(8); PG8_WAIT_L(0); PG8_BAR; PG8_MMA(1, 0, At, B0); PG8_MMA(1, 1, At, B1); PG8_BAR; PG8_SCHED;
            } else {
            PG8_LDB(B0, 0, 0); PG8_SCHED; PG8_LDA(At, 0, 0); PG8_STAGE(PG8_SA(1, 1), rA, a1 + hstep, voffA);
            PG8_WAIT_L(8); PG8_BAR; PG8_WAIT_L(0); PG8_MMA(0, 0, At, B0); PG8_BAR; PG8_SCHED;
            PG8_LDB(B1, 0, 1); PG8_STAGE(PG8_SB(0, 0), rB, b2, voffB);
            PG8_BAR; PG8_WAIT_L(0); PG8_MMA(0, 1, At, B1); PG8_BAR;
            PG8_LDA(At, 0, 1); PG8_STAGE(PG8_SA(0, 0), rA, a2, voffA);
            PG8_BAR; PG8_WAIT_L(0); PG8_MMA(1, 0, At, B0); PG8_BAR; PG8_SCHED;
            PG8_STAGE(PG8_SB(0, 1), rB, b2 + hstep, voffB);
            PG8_WAIT_V(6); PG8_BAR; PG8_MMA(1, 1, At, B1); PG8_BAR;
            PG8_LDB(B0, 1, 0); PG8_SCHED; PG8_LDA(At, 1, 0); PG8_STAGE(PG8_SA(0, 1), rA, a2 + hstep, voffA);
            PG8_WAIT_L(8); PG8_BAR; PG8_WAIT_L(0); PG8_MMA(0, 0, At, B0); PG8_BAR; PG8_SCHED;
            PG8_LDB(B1, 1, 1); PG8_STAGE(PG8_SB(1, 0), rB, b3, voffB);
            PG8_BAR; PG8_WAIT_L(0); PG8_MMA(0, 1, At, B1); PG8_BAR;
            PG8_LDA(At, 1, 1); PG8_STAGE(PG8_SA(1, 0), rA, a3, voffA);
            PG8_BAR; PG8_WAIT_L(0); PG8_MMA(1, 0, At, B0); PG8_BAR; PG8_SCHED;
            PG8_STAGE(PG8_SB(1, 1), rB, b3 + hstep, voffB);
            PG8_WAIT_V(6); PG8_BAR; PG8_MMA(1, 1, At, B1); PG8_BAR;
            }
        }
        if constexpr (ESZ == 1) asm volatile("s_nop 15\n\ts_nop 15" ::: "memory");
        if constexpr (ALIGN_EPI) { if (wr == 0) PG8_BAR; }
        if constexpr (!Epi::AFTER_DRAIN) { Unit ue_ = cur; asm volatile("" : "+s"(ue_.pm), "+s"(ue_.pn));
            if constexpr (Epi::LDS_SCALES) E(acc, ue_, wr, wc, fr, fq, (const PG8_LAS float*)(lds + 131072)); else E(acc, ue_, wr, wc, fr, fq); S.done(cur); }
        if (!has_next) break;
#pragma unroll
        for (int a = 0; a < 2; ++a)
#pragma unroll
            for (int b = 0; b < 2; ++b)
#pragma unroll
                for (int m = 0; m < 4; ++m)
#pragma unroll
                    for (int n = 0; n < 2; ++n) { typedef double f64x2_ __attribute__((ext_vector_type(2))); f64x2_ z_; asm volatile("v_mov_b64 %0, 0" : "=v"(z_.x)); asm volatile("v_mov_b64 %0, 0" : "=v"(z_.y)); acc[a][b][m][n] = __builtin_bit_cast(f32x4, z_); }
        cur = nxt; cA = nA; cB = nB; ++ui;
        if constexpr (ALIGN_EPI) { if (wr == 1) PG8_BAR; }
    }
    PG8_WAIT_V(0);
    if constexpr (!ALIGN_EPI) { if (wr == 0) PG8_BAR; }
    PG8_BAR;
    if constexpr (Epi::AFTER_DRAIN) { E.fused(acc, cur, wr, wc, fr, fq, lds, wid, lane); S.done(cur); }
#undef PG8_SA
#undef PG8_SB
#undef PG8_STAGE
#undef PG8_LDA
#undef PG8_LDB
#undef PG8_MMA
#undef PG8_WAIT_V
#undef PG8_WAIT_L
#undef PG8_BAR
#undef PG8_SCHED
}
}
#define LAS __attribute__((address_space(3)))
#define XB_TMO      128
#define XB_XCNT(j)  (256  + 64 * (j))
#define XB_XSUB(j)  (1280 + 64 * (j))
#define XB_XGEN(j)  (2304 + 64 * (j))
#define XB_TOP      3328
#define XB_TOPGEN   3392
#define XCD_BAR_WORDS 3456
#define XB_SPIN_CAP (1u << 18)

__device__ __forceinline__ unsigned xb_ld(unsigned* p)              { return __hip_atomic_load(p, __ATOMIC_RELAXED, __HIP_MEMORY_SCOPE_AGENT); }
__device__ __forceinline__ unsigned xb_add(unsigned* p, unsigned v) { return __hip_atomic_fetch_add(p, v, __ATOMIC_RELAXED, __HIP_MEMORY_SCOPE_AGENT); }
__device__ __forceinline__ unsigned xb_xcc_id() { return (unsigned)__builtin_amdgcn_s_getreg((3 << 11) | 20) & 0xFu; }
#define XB_SPIN(cond, bar) do { unsigned _sp = 0; while (cond) { __builtin_amdgcn_s_sleep(1); \
    if ((++_sp & 255u) == 0u) { if (xb_ld(&(bar)[XB_TMO])) break; if (_sp > XB_SPIN_CAP) { atomicAdd(&(bar)[XB_TMO], 1u); break; } } } } while (0)

struct XcdBarrier {
    unsigned* bar; unsigned x; unsigned wv;
    volatile LAS unsigned* st;
};

__device__ __forceinline__ unsigned xb_lane() { return (unsigned)pg8::lane_id_fresh(); }
__device__ __forceinline__ XcdBarrier xcd_barrier_post(unsigned* bar, volatile LAS unsigned* st) {
    XcdBarrier b; b.bar = bar; b.x = xb_xcc_id(); b.st = st; b.wv = (unsigned)__builtin_amdgcn_readfirstlane((int)(threadIdx.x >> 6));
    if (threadIdx.x == 0) (void)xb_add(&bar[XB_XCNT(b.x)], 1u);
    return b;
}
__device__ __forceinline__ void xcd_barrier_complete(unsigned* bar, unsigned x, unsigned& nloc, unsigned& nx) {
    const unsigned G = gridDim.x * gridDim.y * gridDim.z;
    unsigned sum, cnt, mine, sp = 0u;
    for (;;) {
        sum = 0u; cnt = 0u; mine = 0u;
#pragma unroll
        for (unsigned j = 0; j < 16; ++j) { const unsigned c = xb_ld(&bar[XB_XCNT(j)]); sum += c; cnt += (c > 0u) ? 1u : 0u; mine = (j == x) ? c : mine; }
        if (sum == G) break;
        __builtin_amdgcn_s_sleep(1);
        if ((++sp & 255u) == 0u) { if (xb_ld(&bar[XB_TMO])) break; if (sp > XB_SPIN_CAP) { atomicAdd(&bar[XB_TMO], 1u); break; } }
    }
    nloc = mine > 0u ? mine : 1u; nx = cnt > 0u ? cnt : 1u;
}

__device__ __forceinline__ void xcd_barrier(const XcdBarrier& b) {
    asm volatile("s_waitcnt vmcnt(0)" ::: "memory");
    __syncthreads();
    if (b.wv == 0u && xb_lane() == 0u) {
        unsigned* bar = b.bar;
        __builtin_amdgcn_s_waitcnt(0);
        unsigned nloc = b.st[0], nx = b.st[1];
        if (nloc == 0u) { xcd_barrier_complete(bar, b.x, nloc, nx); b.st[0] = nloc; b.st[1] = nx; }
        const unsigned old = xb_add(&bar[XB_XSUB(b.x)], 1u);
        const unsigned gen = old / nloc;
        if (old + 1u == (gen + 1u) * nloc) {
            __builtin_amdgcn_fence(__ATOMIC_RELEASE, "agent");
            asm volatile("s_waitcnt vmcnt(0)" ::: "memory");
            const unsigned og = xb_add(&bar[XB_TOP], 1u);
            const unsigned tg = og / nx;
            if (og + 1u == (tg + 1u) * nx) xb_add(&bar[XB_TOPGEN], 1u);
            else XB_SPIN(xb_ld(&bar[XB_TOPGEN]) == tg, bar);
            __builtin_amdgcn_fence(__ATOMIC_ACQUIRE, "agent");
            xb_add(&bar[XB_XGEN(b.x)], 1u);
            asm volatile("s_waitcnt vmcnt(0)" ::: "memory");
        } else {
            XB_SPIN(xb_ld(&bar[XB_XGEN(b.x)]) == gen, bar);
            __builtin_amdgcn_fence(__ATOMIC_ACQUIRE, "agent");
            asm volatile("s_waitcnt vmcnt(0)" ::: "memory");
        }
    }
    __syncthreads();
}
constexpr int DM = 2048, DFF = 5632, SEQ = 2048, DEPTH = 4, NSEQ = 24, NTOK = NSEQ * SEQ;
constexpr int TC = 16384, NCHUNK = NTOK / TC;
constexpr int NH = 12, HD = 128, ATTW = 1536, QKVW = 13824, INW = 14336, POOLW = 512;
constexpr int NGU = 2 * DFF;
constexpr float LOG2E = 1.4426950408889634f;
constexpr float QSCALE = 0.08838834764831845f * LOG2E;
constexpr int NSTEPS = 1 + NCHUNK * DEPTH * 8 + 1;

constexpr size_t MiB = 1u << 20;
constexpr size_t WS_CTL = 0, WS_CM = 1 * MiB, CTL_ZERO_BYTES = 2 * MiB;
constexpr int CM_IN = 0, CM_GU = 65536;
static_assert(DEPTH * 14336 <= CM_GU && (size_t)(CM_GU + 2 * DEPTH * 11264) * 4 <= 1 * MiB, "column-maxima map");
#ifndef DUP_GU8
#define DUP_GU8 1
#endif
#ifndef DUP_IN8
#define DUP_IN8 1
#endif
#ifndef ATT_SPLIT
#define ATT_SPLIT 1024
#endif
#ifndef I8_POOLIN
#define I8_POOLIN 0
#endif
#ifndef I8GU_MASK
#define I8GU_MASK 0xFFu
#endif
constexpr size_t WS_SR = 4 * MiB + 512 * 1024;
constexpr size_t WS_SA = 4 * MiB + 256 * 1024;
constexpr size_t WS_LUT = 4 * MiB, WS_WPT = 5 * MiB, WS_LSE = 6 * MiB;
constexpr size_t WS_W = 16 * MiB, W_LAYER = 196 * MiB;
constexpr size_t WO_GU0 = 0, WO_GU1 = 44 * MiB, WO_D0 = 88 * MiB, WO_D1 = 110 * MiB, WO_IN = 132 * MiB  , WO_INU = 160 * MiB  , WO_OUT = 188 * MiB;
constexpr float W8_SCALE = 64.0f;
constexpr size_t WS_XB = 800 * MiB, WS_H = 992 * MiB, WS_OG = WS_H, WS_Z = 1168 * MiB, WS_MIX = 1616 * MiB, WS_SS = 1680 * MiB, WS_XB8 = 1760 * MiB, WS_END = 1856 * MiB;
static_assert((size_t)NGU * DM * 2 == 44 * MiB && (size_t)DM * DFF * 2 == 22 * MiB && (size_t)INW * DM * 2 == 56 * MiB && (size_t)DM * DM * 2 == 8 * MiB, "weight map");
static_assert((size_t)NTOK * DM * 2 == 192 * MiB && (size_t)TC * DFF * 2 == 176 * MiB && (size_t)TC * INW * 2 == 448 * MiB && (size_t)TC * DM * 2 == 64 * MiB && (size_t)TC * 3 * ATTW * 2 <= 176 * MiB, "activation map");
static_assert(13 * (size_t)NTOK * 32 * 4 <= 80 * MiB && (size_t)TC * 36 * 4 <= 10 * MiB, "small buffers");
constexpr int CW_BAR = 4096;

constexpr int LDS_BYTES = 147456;
constexpr int ATT_K = 0, ATT_KP = 272, ATT_V = 256 * ATT_KP, ATT_VP = 288, ATT_LUT = ATT_V + 256 * ATT_VP;
constexpr int MISC_OFF = 146432;
static_assert(ATT_LUT + 768 <= MISC_OFF && MISC_OFF + 64 <= LDS_BYTES, "LDS map");

#define GAS __attribute__((address_space(1)))
typedef unsigned short bf16;
typedef unsigned u32x4 __attribute__((ext_vector_type(4)));
typedef unsigned u32x2 __attribute__((ext_vector_type(2)));
typedef float f32x4 __attribute__((ext_vector_type(4)));
typedef short bf16x8 __attribute__((ext_vector_type(8)));
typedef short s16x4 __attribute__((ext_vector_type(4)));
using pg8::cvt_pk_bf16;
#define LDS_WAIT() asm volatile("s_waitcnt lgkmcnt(0)" ::: "memory")
#define LDS_BARRIER() asm volatile("s_waitcnt lgkmcnt(0)\n\ts_barrier" ::: "memory")
__device__ __forceinline__ float bf_lo(unsigned w) { return __uint_as_float(w << 16); }
__device__ __forceinline__ float bf_hi(unsigned w) { return __uint_as_float(w & 0xffff0000u); }
__device__ __forceinline__ float wave_sum(float v) {
#pragma unroll
    for (int o = 1; o < 64; o <<= 1) v += __shfl_xor(v, o);
    return v;
}

#define W_OFF(n, kb, Kb) (PG8_B_BLOCKED ? pg8::bblk_off((n), (kb), (Kb)) : ((size_t)(n) * (size_t)(Kb) + (size_t)(kb)))
struct CvtItem { const float* src; const float* gk; unsigned char* dst; float* cm; int ldn, k0, c0, ldk, r0, fp8  ; float cs; };
__device__ __forceinline__ void cvt_colmax(const CvtItem& I, const float (&lv)[32], int lane) {
    float m = 0.f;
#pragma unroll
    for (int i = 0; i < 32; ++i) { const int kk = 2 * i + (lane >> 5); m = fmaxf(m, fabsf(lv[i] * (I.gk ? I.gk[I.k0 + kk] : 1.0f))); }
    m = fmaxf(m, __shfl_xor(m, 32));
    if (lane < 32) atomicMax((unsigned*)(I.cm + I.r0 + lane), __float_as_uint(m));
}
__device__ __forceinline__ void cvt_load(const CvtItem& I, float (&lv)[32], int lane) {
#pragma unroll
    for (int i = 0; i < 32; ++i) { const int kk = 2 * i + (lane >> 5); lv[i] = I.src[(size_t)(I.k0 + kk) * I.ldn + I.c0 + (lane & 31)]; }
}
__device__ __forceinline__ void cvt_store(const CvtItem& I, const float (&lv)[32], LAS float* scr, int lane) {
#pragma unroll
    for (int i = 0; i < 32; ++i) { const int kk = 2 * i + (lane >> 5); scr[kk * 33 + (lane & 31)] = lv[i]; }
    const int c = lane & 7;
    float gs[8];
#pragma unroll
    for (int j = 0; j < 8; ++j) gs[j] = I.gk ? I.gk[I.k0 + 8 * c + j] * I.cs : I.cs;
    LDS_WAIT(); asm volatile("" ::: "memory");
#pragma unroll
    for (int j = 0; j < 4; ++j) { const int n = (lane >> 3) + 8 * j; const LAS float* s = scr + (8 * c) * 33 + n;
        float v[8];
#pragma unroll
        for (int q = 0; q < 8; ++q) v[q] = s[q * 33] * gs[q];
        if (I.fp8) { const float cmv = I.cm[I.r0 + n], inv = cmv > 0.f ? 127.0f / cmv : 0.f; int q8[8];
#pragma unroll
            for (int q = 0; q < 8; ++q) { int t = (int)__builtin_rintf(v[q] * inv); t = t < -127 ? -127 : (t > 127 ? 127 : t); q8[q] = t & 0xff; }
            u32x2 o; o.x = (unsigned)q8[0] | ((unsigned)q8[1] << 8) | ((unsigned)q8[2] << 16) | ((unsigned)q8[3] << 24); o.y = (unsigned)q8[4] | ((unsigned)q8[5] << 8) | ((unsigned)q8[6] << 16) | ((unsigned)q8[7] << 24);
            *(u32x2*)(I.dst + W_OFF(I.r0 + n, I.k0 + 8 * c, I.ldk)) = o; }
        else { u32x4 o; o.x = cvt_pk_bf16(v[0], v[1]); o.y = cvt_pk_bf16(v[2], v[3]); o.z = cvt_pk_bf16(v[4], v[5]); o.w = cvt_pk_bf16(v[6], v[7]);
            *(u32x4*)(I.dst + W_OFF(I.r0 + n, (I.k0 + 8 * c) * 2, I.ldk * 2)) = o; } }
    LDS_WAIT(); asm volatile("" ::: "memory");
}
__device__ __forceinline__ void cvt_store8(const CvtItem& I, const float (&lv)[32], LAS float* scr, int lane, float cmv) {
#pragma unroll
    for (int i = 0; i < 32; ++i) { const int kk = 2 * i + (lane >> 5); scr[kk * 33 + (lane & 31)] = lv[i]; }
    const int c = lane & 7;
    float gs[8];
#pragma unroll
    for (int j = 0; j < 8; ++j) gs[j] = I.gk[I.k0 + 8 * c + j];
    LDS_WAIT(); asm volatile("" ::: "memory");
#pragma unroll
    for (int j = 0; j < 4; ++j) { const int n = (lane >> 3) + 8 * j; const LAS float* s = scr + (8 * c) * 33 + n;
        const float cmn = __shfl(cmv, n), inv = cmn > 0.f ? 127.0f / cmn : 0.f; int q8[8];
#pragma unroll
        for (int q = 0; q < 8; ++q) { int t = (int)__builtin_rintf(s[q * 33] * gs[q] * inv); t = t < -127 ? -127 : (t > 127 ? 127 : t); q8[q] = t & 0xff; }
        u32x2 o; o.x = (unsigned)q8[0] | ((unsigned)q8[1] << 8) | ((unsigned)q8[2] << 16) | ((unsigned)q8[3] << 24); o.y = (unsigned)q8[4] | ((unsigned)q8[5] << 8) | ((unsigned)q8[6] << 16) | ((unsigned)q8[7] << 24);
        *(u32x2*)(I.dst + W_OFF(I.r0 + n, I.k0 + 8 * c, I.ldk)) = o; }
    LDS_WAIT(); asm volatile("" ::: "memory");
}
__device__ __forceinline__ int t5_bucket(int rel) {
    const int n = rel < 0 ? -rel : rel; int b;
    if (n < 8) b = n; else if (n < 15) b = 8; else if (n < 27) b = 9; else if (n < 50) b = 10; else if (n < 91) b = 11; else if (n < 166) b = 12; else if (n < 305) b = 13; else if (n < 559) b = 14; else b = 15;
    return b + (rel > 0 ? 16 : 0);
}
struct Ptrs {
    const float *x_prompt, *x_sample, *norm_g, *ffn_gate, *ffn_up, *ffn_down, *w_in, *w_pool, *pool_scale, *w_out, *rel_bias, *final_g;
    float* out; unsigned char* ws;
};
__device__ __forceinline__ void prologue(const Ptrs& P, LAS unsigned char* lds, int tid, int lane, int wave, int G, int pass) {
    LAS float* scr = (LAS float*)(lds + wave * 8448);
    const int gw = blockIdx.x * 8 + wave, NGW = G * 8;
    constexpr int I_GU = 32 * 352, I_D = 88 * 64, I_IN = 32 * 448, I_OUT = 32 * 64, I_LAYER = 2 * I_GU + 2 * I_D + I_IN + I_OUT;
    auto decode = [&](int it) -> CvtItem {
        CvtItem I; const int l = it / I_LAYER; int r = it % I_LAYER;
        unsigned char* wl = P.ws + WS_W + (size_t)l * W_LAYER; I.fp8 = 0; I.cs = 1.0f; I.cm = nullptr; float* CM = (float*)(P.ws + WS_CM);
        if (r < 2 * I_GU) { const int j = r / I_GU; r %= I_GU; const int kb = r / 352, nb = r % 352, n0 = 32 * nb, pn = n0 >> 8, within = n0 & 255;
            I.src = ((within < 128) ? P.ffn_gate : P.ffn_up) + (size_t)(l * 2 + j) * DM * DFF; I.ldn = DFF; I.k0 = 64 * kb; I.c0 = 128 * pn + (within & 127);
            I.dst = wl + (j ? WO_GU1 : WO_GU0); I.ldk = DM; I.r0 = n0; I.gk = P.norm_g + (size_t)(l * 3 + 2 * j) * DM;
            if ((I8GU_MASK >> (l * 2 + j)) & 1u) { I.fp8 = 2; I.cm = CM + CM_GU + (l * 2 + j) * NGU; }
            return I; }
        r -= 2 * I_GU;
        if (r < 2 * I_D) { const int j = r / I_D; r %= I_D; const int kb = r / 64, nb = r % 64;
            I.src = P.ffn_down + (size_t)(l * 2 + j) * DFF * DM; I.ldn = DM; I.k0 = 64 * kb; I.c0 = 32 * nb; I.dst = wl + (j ? WO_D1 : WO_D0); I.ldk = DFF; I.r0 = 32 * nb; I.gk = nullptr; return I; }
        r -= 2 * I_D;
        if (r < I_IN) { const int kb = r / 448, nb = r % 448, n0 = 32 * nb;
            I.src = P.w_in + (size_t)l * DM * INW; I.ldn = INW; I.k0 = 64 * kb; I.c0 = n0; I.ldk = DM; I.gk = P.norm_g + (size_t)(l * 3 + 1) * DM;
#if I8_POOLIN
            I.dst = wl + WO_IN; I.r0 = n0; I.fp8 = 2; I.cm = CM + CM_IN + l * INW;
#else
            if (n0 < QKVW) { I.dst = wl + WO_IN; I.r0 = n0; I.fp8 = 2; I.cm = CM + CM_IN + l * INW; } else { I.dst = wl + WO_INU; I.r0 = n0 - QKVW; }
#endif
            return I; }
        r -= I_IN;
        { const int kb = r / 64, nb = r % 64;
            I.src = P.w_out + (size_t)l * DM * DM; I.ldn = DM; I.k0 = 64 * kb; I.c0 = 32 * nb; I.dst = wl + WO_OUT; I.ldk = DM; I.r0 = 32 * nb; I.gk = nullptr; return I; }
    };
    {
        LAS float* cmx = (LAS float*)(lds + 69632);
        constexpr int S_LAYER = 2 * 352 + 432;
        for (int sidx = blockIdx.x; sidx < DEPTH * S_LAYER; sidx += G) {
            const int l = sidx / S_LAYER, r = sidx % S_LAYER; int itb, kstride;
            if (r < 704) { const int j = r / 352; if (!((I8GU_MASK >> (l * 2 + j)) & 1u)) continue; itb = l * I_LAYER + j * I_GU + (r % 352); kstride = 352; }
            else { itb = l * I_LAYER + 2 * I_GU + 2 * I_D + (r - 704); kstride = 448; }
            float lv[4][32];
#pragma unroll
            for (int b = 0; b < 4; ++b) { const CvtItem I = decode(itb + (4 * wave + b) * kstride); cvt_load(I, lv[b], lane); }
            float m = 0.f;
#pragma unroll
            for (int b = 0; b < 4; ++b) { const CvtItem I = decode(itb + (4 * wave + b) * kstride);
#pragma unroll
                for (int i = 0; i < 32; ++i) { const int kk = 2 * i + (lane >> 5); m = fmaxf(m, fabsf(lv[b][i] * I.gk[I.k0 + kk])); } }
            m = fmaxf(m, __shfl_xor(m, 32));
            if (lane < 32) cmx[wave * 32 + lane] = m;
            __syncthreads();
            float cmv = 0.f;
#pragma unroll
            for (int w = 0; w < 8; ++w) cmv = fmaxf(cmv, cmx[w * 32 + (lane & 31)]);
            { const CvtItem I = decode(itb); if (wave == 0 && lane < 32) I.cm[I.r0 + lane] = cmv; }
#pragma unroll
            for (int b = 0; b < 4; ++b) { const CvtItem I = decode(itb + (4 * wave + b) * kstride); cvt_store8(I, lv[b], scr, lane, cmv); }
            __syncthreads();
        }
    }
    {
        constexpr int NIT = DEPTH * I_LAYER;
        auto next16 = [&](int it) -> int { while (it < NIT && decode(it).fp8 == 2) it += NGW; return it; };
        int itA = next16(gw), itB = (itA < NIT) ? next16(itA + NGW) : NIT; float lvA[32], lvB[32]; CvtItem curA, curB;
        if (itA < NIT) { curA = decode(itA); cvt_load(curA, lvA, lane); } else curA = decode(0);
        curB = curA; if (itB < NIT) { curB = decode(itB); cvt_load(curB, lvB, lane); }
        while (itA < NIT) {
            float lcA[32], lcB[32];
#pragma unroll
            for (int i = 0; i < 32; ++i) { lcA[i] = lvA[i]; lcB[i] = lvB[i]; }
            const int itA2 = (itB < NIT) ? next16(itB + NGW) : NIT, itB2 = (itA2 < NIT) ? next16(itA2 + NGW) : NIT; CvtItem nA = curA, nB = curB;
            if (itA2 < NIT) { nA = decode(itA2); cvt_load(nA, lvA, lane); }
            if (itB2 < NIT) { nB = decode(itB2); cvt_load(nB, lvB, lane); }
            asm volatile("" ::: "memory");
            cvt_store(curA, lcA, scr, lane);
            if (itB < NIT) cvt_store(curB, lcB, scr, lane);
            curA = nA; curB = nB; itA = itA2; itB = itB2;
        }
    }
    bf16* XB = (bf16*)(P.ws + WS_XB); float* SS = (float*)(P.ws + WS_SS);
    for (int rowa = gw; rowa < NTOK; rowa += 2 * NGW) {
        f32x4 v[2][8]; float s[2];
#pragma unroll
        for (int h = 0; h < 2; ++h) { const int row = rowa + h * NGW; s[h] = 0.f;
            if (row < NTOK) { const float* xr = (row < 16 * SEQ) ? P.x_prompt + (size_t)row * DM : P.x_sample + (size_t)(row - 16 * SEQ) * DM;
#pragma unroll
                for (int j = 0; j < 8; ++j) v[h][j] = *(const f32x4*)(xr + 4 * lane + 256 * j); }
            else {
#pragma unroll
                for (int j = 0; j < 8; ++j) v[h][j] = (f32x4){0.f, 0.f, 0.f, 0.f}; } }
#pragma unroll
        for (int h = 0; h < 2; ++h) { const int row = rowa + h * NGW; if (row >= NTOK) continue;
#pragma unroll
            for (int j = 0; j < 8; ++j) s[h] += (v[h][j][0] * v[h][j][0] + v[h][j][1] * v[h][j][1]) + (v[h][j][2] * v[h][j][2] + v[h][j][3] * v[h][j][3]);
            s[h] = wave_sum(s[h]);
#pragma unroll
            for (int j = 0; j < 8; ++j) { u32x2 o; o.x = cvt_pk_bf16(v[h][j][0], v[h][j][1]); o.y = cvt_pk_bf16(v[h][j][2], v[h][j][3]); *(u32x2*)(XB + (size_t)row * DM + 4 * lane + 256 * j) = o; }
            if (lane < 32) SS[(size_t)row * 32 + lane] = (lane == 0) ? s[h] : 0.f; }
    }
    float* LUT = (float*)(P.ws + WS_LUT);
    for (int i = blockIdx.x * 512 + tid; i < 36 * 192; i += G * 512) { const int gh = i / 192, idx = i % 192, d64 = idx - 16, g = gh / 12, dil = (g == 0) ? 1 : (g == 1 ? 4 : 16);
        LUT[i] = (d64 >= 0 && d64 <= 128) ? P.rel_bias[t5_bucket((d64 - 64) * dil) * 36 + gh] * LOG2E : -1e30f; }
    bf16* WPT = (bf16*)(P.ws + WS_WPT);
    for (int i = blockIdx.x * 512 + tid; i < DEPTH * 4 * 128 * 128; i += G * 512) { const int c = i & 127, e = (i >> 7) & 127, lg = i >> 14;
        WPT[i] = (bf16)(cvt_pk_bf16(P.w_pool[(size_t)lg * 16384 + c * 128 + e], 0.f) & 0xffffu); }
}

#ifndef QR
#define QR 4
#endif
template <bool WR> __device__ __forceinline__ void quant_rows(const bf16* __restrict__ xb, unsigned char* __restrict__ x8, float* __restrict__ sa, float* __restrict__ sr, const float* __restrict__ ssp, int lane, int wave, int G_) {
    const int gw = blockIdx.x * 8 + wave, NGW = G_ * 8;
    for (int rb = gw; rb < TC; rb += QR * NGW) {
        u32x4 v[QR][4]; float am[QR];
#pragma unroll
        for (int q = 0; q < QR; ++q) { const int row = rb + q * NGW;
#pragma unroll
            for (int j = 0; j < 4; ++j) v[q][j] = (row < TC) ? *(const u32x4*)(xb + (size_t)row * DM + 8 * lane + 512 * j) : (u32x4){0u, 0u, 0u, 0u}; }
#pragma unroll
        for (int q = 0; q < QR; ++q) { float a = 0.f;
#pragma unroll
            for (int j = 0; j < 4; ++j)
#pragma unroll
                for (int k = 0; k < 4; ++k) a = fmaxf(a, fmaxf(fabsf(bf_lo(v[q][j][k])), fabsf(bf_hi(v[q][j][k]))));
#pragma unroll
            for (int o = 1; o < 64; o <<= 1) a = fmaxf(a, __shfl_xor(a, o));
            am[q] = a; }
#pragma unroll
        for (int q = 0; q < QR; ++q) { const int row = rb + q * NGW; if (row >= TC) continue;
            const float inv = am[q] > 0.f ? 127.0f / am[q] : 0.f;
            { float sp = (lane < 32) ? ssp[(size_t)row * 32 + lane] : 0.f;
#pragma unroll
              for (int o = 1; o < 32; o <<= 1) sp += __shfl_xor(sp, o);
              const float rstd = __builtin_amdgcn_rsqf(sp * pg8::INV_D + pg8::RMS_EPS);
              if (lane == 0) { sa[row] = am[q] * (1.0f / 127.0f) * rstd; if (WR) sr[row] = rstd; } }
#pragma unroll
            for (int j = 0; j < 4; ++j) { u32x2 o; int q8[8];
#pragma unroll
                for (int k = 0; k < 4; ++k) { int t0 = (int)__builtin_rintf(bf_lo(v[q][j][k]) * inv), t1 = (int)__builtin_rintf(bf_hi(v[q][j][k]) * inv);
                    t0 = t0 < -127 ? -127 : (t0 > 127 ? 127 : t0); t1 = t1 < -127 ? -127 : (t1 > 127 ? 127 : t1); q8[2 * k] = t0 & 0xff; q8[2 * k + 1] = t1 & 0xff; }
                o.x = (unsigned)q8[0] | ((unsigned)q8[1] << 8) | ((unsigned)q8[2] << 16) | ((unsigned)q8[3] << 24); o.y = (unsigned)q8[4] | ((unsigned)q8[5] << 8) | ((unsigned)q8[6] << 16) | ((unsigned)q8[7] << 24);
                *(u32x2*)(x8 + (size_t)row * DM + 8 * lane + 512 * j) = o; } }
    }
}

struct AttnUnit { const bf16* zb; size_t tstride; int L, i0, dil, gh, tokbase, nsteps; };
template <int MODE> __device__ __forceinline__ AttnUnit attn_decode(const bf16* z, int u) {
    AttnUnit a; int bh, g, c, seg;
    if (MODE) { bh = u >> 3; g = 0; c = 0; seg = u & 7; a.dil = 1; a.nsteps = 2; }
    else if (u < 768) { bh = u >> 3; g = 1; c = (u & 7) >> 1; seg = u & 1; a.dil = 4; a.nsteps = 2; }
    else { const int v = u - 768; bh = v >> 4; g = 2; c = v & 15; seg = 0; a.dil = 16; a.nsteps = 1; }
    const int b = bh / NH, h = bh % NH;
    a.L = SEQ / a.dil; a.i0 = seg * 256; a.tstride = (size_t)a.dil * INW; a.gh = g * NH + h; a.tokbase = b * SEQ + c;
    a.zb = z + (size_t)a.tokbase * INW + g * 4608 + h * HD;
    return a;
}
struct AttnRegs { u32x4 kv[8], vv[8]; bf16x8 qf[4]; float lutv; };
__device__ __forceinline__ void attn_issue(const AttnUnit& a, int i0s, bool first, AttnRegs& R, const float* __restrict__ lutg, int tid, int lane, int wave) {
    const int kstart = i0s - 64, sb = i0s & 255;
#pragma unroll
    for (int it = 0; it < 8; ++it) { const int id = tid + 512 * it, slot = id >> 4, cc = id & 15, p = (slot - sb) & 255, ki = kstart + p;
        R.kv[it] = (u32x4){0u, 0u, 0u, 0u}; R.vv[it] = (u32x4){0u, 0u, 0u, 0u};
        if ((first || p >= 128) && ki >= 0 && ki < a.L) { const bf16* q = a.zb + (size_t)ki * a.tstride + cc * 8; R.kv[it] = *(const u32x4*)(q + 1536); R.vv[it] = *(const u32x4*)(q + 3072); } }
    const bf16* qp = a.zb + (size_t)(i0s + 16 * wave + (lane & 15)) * a.tstride + 8 * (lane >> 4);
#pragma unroll
    for (int ks = 0; ks < 4; ++ks) R.qf[ks] = *(const bf16x8*)(qp + 32 * ks);
    R.lutv = (tid < 192) ? lutg[a.gh * 192 + tid] : 0.f;
}
template <int MODE> __device__ __forceinline__ void attn_phase(const bf16* __restrict__ z, bf16* og, float* lse, bf16* __restrict__ mix, const float* __restrict__ lutg, LAS unsigned char* lds, int tid, int lane, int wave, int u0, int G_, int nunits) {
    if (u0 >= nunits) return;
    const int qi = lane & 15, G = lane >> 4;
    LAS unsigned char* Kl = lds + ATT_K; LAS unsigned char* Vl = lds + ATT_V; LAS float* lut = (LAS float*)(lds + ATT_LUT);
    int u = u0, st = 0; AttnUnit cur = attn_decode<MODE>(z, u); AttnRegs R; attn_issue(cur, cur.i0, true, R, lutg, tid, lane, wave);
#if defined(DUP_ATTX)
    int reps_left = (MODE == DUP_ATTX_MODE) ? DUP_ATTX - 1 : 0;
#endif
    for (;;) {
        const int i0s = cur.i0 + 128 * st, sb = i0s & 255; const bool first = (st == 0);
#pragma unroll
        for (int it = 0; it < 8; ++it) { const int id = tid + 512 * it, slot = id >> 4, cc = id & 15, p = (slot - sb) & 255;
            if (first || p >= 128) { *(LAS u32x4*)(Kl + slot * ATT_KP + cc * 16) = R.kv[it]; *(LAS u32x4*)(Vl + slot * ATT_VP + cc * 16) = R.vv[it]; } }
        if (tid < 192) lut[tid] = R.lutv;
        bf16x8 qf[4];
#pragma unroll
        for (int ks = 0; ks < 4; ++ks) qf[ks] = R.qf[ks];
        LDS_BARRIER();
        int un = u, stn = st + 1; AttnUnit nxt = cur; bool has_next = true;
        if (stn >= cur.nsteps) { un = u + G_; stn = 0; has_next = un < nunits;
#if defined(DUP_ATTX)
            if (!has_next && reps_left > 0) { --reps_left; un = u0; has_next = true; }
#endif
            if (has_next) nxt = attn_decode<MODE>(z, un); }
        if (has_next) attn_issue(nxt, nxt.i0 + 128 * stn, stn == 0, R, lutg, tid, lane, wave);
        asm volatile("" ::: "memory");
        const int L = cur.L, kw0 = 16 * wave, kbase = i0s - 64 + kw0;
        const size_t tokrow = (size_t)cur.tokbase + (size_t)(i0s + 16 * wave + qi) * cur.dil;
        f32x4 s[9];
        {
            const int rb = sb + kw0 + qi;
            const LAS unsigned char* kcol = Kl + 16 * G;
            bf16x8 ka[2][4];
#pragma unroll
            for (int ks = 0; ks < 4; ++ks) ka[0][ks] = *(const LAS bf16x8*)(kcol + (rb & 255) * ATT_KP + 64 * ks);
#pragma unroll
            for (int kt = 0; kt < 9; ++kt) {
                if (kt + 1 < 9) {
#pragma unroll
                    for (int ks = 0; ks < 4; ++ks) ka[(kt + 1) & 1][ks] = *(const LAS bf16x8*)(kcol + ((rb + 16 * (kt + 1)) & 255) * ATT_KP + 64 * ks); }
                f32x4 a4 = (f32x4){0.f, 0.f, 0.f, 0.f};
#pragma unroll
                for (int ks = 0; ks < 4; ++ks) a4 = __builtin_amdgcn_mfma_f32_16x16x32_bf16(ka[kt & 1][ks], qf[ks], a4, 0, 0, 0);
                s[kt] = a4; }
        }
        float m = -3.0e38f;
        {
            const LAS float* lb = lut + (4 * G - qi + 16);
            float bv[9][4];
#pragma unroll
            for (int kt = 0; kt < 9; ++kt)
#pragma unroll
                for (int rr = 0; rr < 4; ++rr) bv[kt][rr] = lb[16 * kt + rr];
#pragma unroll
            for (int kt = 0; kt < 9; ++kt) { const bool tv = (kbase + 16 * kt >= 0) && (kbase + 16 * kt < L);
#pragma unroll
                for (int rr = 0; rr < 4; ++rr) { const float v = tv ? s[kt][rr] + bv[kt][rr] : -1e30f; s[kt][rr] = v; m = fmaxf(m, v); } }
        }
        m = fmaxf(m, __shfl_xor(m, 16)); m = fmaxf(m, __shfl_xor(m, 32));
        float lsum = 0.f;
#pragma unroll
        for (int kt = 0; kt < 9; ++kt)
#pragma unroll
            for (int rr = 0; rr < 4; ++rr) { const float p = __builtin_amdgcn_exp2f(s[kt][rr] - m); s[kt][rr] = p; lsum += p; }
        lsum += __shfl_xor(lsum, 16); lsum += __shfl_xor(lsum, 32);
        u32x2 o1[8], o2[8]; float l1 = 0.f, l2 = 0.f;
        if (MODE == 1) {
            const bf16* gp = og + tokrow * (3 * ATTW) + cur.gh * HD + 4 * G;
#pragma unroll
            for (int db = 0; db < 8; ++db) { o1[db] = *(const u32x2*)(gp + ATTW + 16 * db); o2[db] = *(const u32x2*)(gp + 2 * ATTW + 16 * db); }
            l1 = lse[tokrow * 36 + 12 + cur.gh]; l2 = lse[tokrow * 36 + 24 + cur.gh];
            asm volatile("" ::: "memory");
        }
        f32x4 o[8];
#pragma unroll
        for (int db = 0; db < 8; ++db) o[db] = (f32x4){0.f, 0.f, 0.f, 0.f};
#pragma unroll
        for (int kp = 0; kp < 5; ++kp) {
            u32x4 pw; pw.x = cvt_pk_bf16(s[2 * kp][0], s[2 * kp][1]); pw.y = cvt_pk_bf16(s[2 * kp][2], s[2 * kp][3]);
            if (kp < 4) { pw.z = cvt_pk_bf16(s[2 * kp + 1][0], s[2 * kp + 1][1]); pw.w = cvt_pk_bf16(s[2 * kp + 1][2], s[2 * kp + 1][3]); } else { pw.z = 0u; pw.w = 0u; }
            const bf16x8 pb = __builtin_bit_cast(bf16x8, pw);
            const int rowA = (sb + kw0 + 32 * kp + 4 * G + (qi >> 2)) & 255, rowB = (rowA + 16) & 255;
            const LAS unsigned char* pa = Vl + rowA * ATT_VP + (qi & 3) * 8; const LAS unsigned char* pbv = Vl + rowB * ATT_VP + (qi & 3) * 8;
#pragma unroll
            for (int db = 0; db < 8; ++db) {
                const s16x4 t0 = __builtin_bit_cast(s16x4, __builtin_amdgcn_ds_read_tr16_b64_v4i16((LAS s16x4*)(pa + db * 32)));
                const s16x4 t1 = __builtin_bit_cast(s16x4, __builtin_amdgcn_ds_read_tr16_b64_v4i16((LAS s16x4*)(pbv + db * 32)));
                const bf16x8 a = (bf16x8){t0[0], t0[1], t0[2], t0[3], t1[0], t1[1], t1[2], t1[3]};
                o[db] = __builtin_amdgcn_mfma_f32_16x16x32_bf16(a, pb, o[db], 0, 0, 0); }
        }
        const float inv = __builtin_amdgcn_rcpf(lsum);
        if (MODE == 0) {
            bf16* op = og + tokrow * (3 * ATTW) + cur.gh * HD + 4 * G;
#pragma unroll
            for (int db = 0; db < 8; ++db) { u32x2 w; w.x = cvt_pk_bf16(o[db][0] * inv, o[db][1] * inv); w.y = cvt_pk_bf16(o[db][2] * inv, o[db][3] * inv); *(u32x2*)(op + 16 * db) = w; }
            if (G == 0) lse[tokrow * 36 + cur.gh] = m + __builtin_amdgcn_logf(lsum);
        } else {
            const float l0 = m + __builtin_amdgcn_logf(lsum), mx = fmaxf(l0, fmaxf(l1, l2));
            float w0 = __builtin_amdgcn_exp2f(l0 - mx), w1 = __builtin_amdgcn_exp2f(l1 - mx), w2 = __builtin_amdgcn_exp2f(l2 - mx);
            const float wi = __builtin_amdgcn_rcpf(w0 + w1 + w2); w0 *= wi * inv; w1 *= wi; w2 *= wi;
            bf16* mp = mix + tokrow * DM + cur.gh * HD + 4 * G;
#pragma unroll
            for (int db = 0; db < 8; ++db) { u32x2 w;
                w.x = cvt_pk_bf16(w0 * o[db][0] + w1 * bf_lo(o1[db].x) + w2 * bf_lo(o2[db].x), w0 * o[db][1] + w1 * bf_hi(o1[db].x) + w2 * bf_hi(o2[db].x));
                w.y = cvt_pk_bf16(w0 * o[db][2] + w1 * bf_lo(o1[db].y) + w2 * bf_lo(o2[db].y), w0 * o[db][3] + w1 * bf_hi(o1[db].y) + w2 * bf_hi(o2[db].y));
                *(u32x2*)(mp + 16 * db) = w; }
        }
        LDS_BARRIER();
        if (!has_next) break;
        cur = nxt; u = un; st = stn;
    }
}

template <int HW> __device__ __forceinline__ void pool_task(const bf16* __restrict__ z, bf16* __restrict__ mix, const bf16* __restrict__ wpt, const float* __restrict__ pscale, int pg, int tile, int lane) {
    const int qi = lane & 15, Gq = lane >> 4, tt = tile * 16 + qi, spos = tt & (SEQ - 1);
    const int lo = (spos - HW) < 0 ? 0 : spos - HW, hi = (spos + HW + 1) > SEQ ? SEQ : spos + HW + 1; const float rc = 1.0f / (float)(hi - lo);
    const bf16* ub = z + (size_t)(tt - spos) * INW + QKVW + pg * 128 + 8 * Gq;
    bf16x8 df[4];
#pragma unroll
    for (int ks = 0; ks < 4; ++ks) { float acc[8];
#pragma unroll
        for (int k = 0; k < 8; ++k) acc[k] = 0.f;
        u32x4 sv;
#pragma unroll
        for (int w0 = 0; w0 < 2 * HW + 1; w0 += 9) {
            constexpr int NB = 9; u32x4 wv[NB];
#pragma unroll
            for (int w = 0; w < NB; ++w) if (w0 + w < 2 * HW + 1) { int sp = spos - HW + w0 + w; sp = sp < 0 ? 0 : (sp > SEQ - 1 ? SEQ - 1 : sp); wv[w] = *(const u32x4*)(ub + (size_t)sp * INW + 32 * ks); }
#pragma unroll
            for (int w = 0; w < NB; ++w) if (w0 + w < 2 * HW + 1) { const int sp = spos - HW + w0 + w; const float msk = (sp >= 0 && sp < SEQ) ? 1.0f : 0.0f;
                if (w0 + w == HW) sv = wv[w];
#pragma unroll
                for (int k = 0; k < 4; ++k) { acc[2 * k] += msk * bf_lo(wv[w][k]); acc[2 * k + 1] += msk * bf_hi(wv[w][k]); } }
            if (2 * HW + 1 > 9) asm volatile("" ::: "memory");
        }
        u32x4 dw;
#pragma unroll
        for (int k = 0; k < 4; ++k) dw[k] = cvt_pk_bf16(acc[2 * k] * rc - bf_lo(sv[k]), acc[2 * k + 1] * rc - bf_hi(sv[k]));
        df[ks] = __builtin_bit_cast(bf16x8, dw);
        asm volatile("" ::: "memory"); }
    const bf16* wb = wpt + (size_t)pg * 16384 + (size_t)qi * 128 + 8 * Gq;
    bf16* mp = mix + (size_t)tt * DM + ATTW + pg * 128 + 4 * Gq;
#pragma unroll
    for (int eb = 0; eb < 8; ++eb) { f32x4 a4 = (f32x4){0.f, 0.f, 0.f, 0.f};
#pragma unroll
        for (int ks = 0; ks < 4; ++ks) { const bf16x8 wf = *(const bf16x8*)(wb + (size_t)eb * 16 * 128 + 32 * ks); a4 = __builtin_amdgcn_mfma_f32_16x16x32_bf16(wf, df[ks], a4, 0, 0, 0); }
        const f32x4 ps = *(const f32x4*)(pscale + pg * 128 + 16 * eb + 4 * Gq);
        u32x2 w; w.x = cvt_pk_bf16(a4[0] * ps[0], a4[1] * ps[1]); w.y = cvt_pk_bf16(a4[2] * ps[2], a4[3] * ps[3]); *(u32x2*)(mp + 16 * eb) = w; }
}
__device__ __forceinline__ void pool_phase(const bf16* __restrict__ z, bf16* __restrict__ mix, const bf16* __restrict__ wpt  , const float* __restrict__ pscale  , int lane, int wave, int G_) {
    const int gw = blockIdx.x * 8 + wave, NGW = G_ * 8;
    for (int tile = (gw + 0 * (NGW / 4)) % NGW; tile < TC / 16; tile += NGW) pool_task<1>(z, mix, wpt, pscale, 0, tile, lane);
    for (int tile = (gw + 1 * (NGW / 4)) % NGW; tile < TC / 16; tile += NGW) pool_task<2>(z, mix, wpt, pscale, 1, tile, lane);
    for (int tile = (gw + 2 * (NGW / 4)) % NGW; tile < TC / 16; tile += NGW) pool_task<4>(z, mix, wpt, pscale, 2, tile, lane);
    for (int tile = (gw + 3 * (NGW / 4)) % NGW; tile < TC / 16; tile += NGW) pool_task<8>(z, mix, wpt, pscale, 3, tile, lane);
}

__device__ __forceinline__ void final_norm(float* out, const bf16* xbf, const float* ss, const float* fg, int lane, int wave, int G_) {
    const int gw = blockIdx.x * 8 + wave, NGW = G_ * 8;
    f32x4 gv[8];
#pragma unroll
    for (int j = 0; j < 4; ++j) { gv[2 * j] = *(const f32x4*)(fg + 8 * lane + 512 * j); gv[2 * j + 1] = *(const f32x4*)(fg + 8 * lane + 512 * j + 4); }
    for (int row = gw; row < NTOK; row += NGW) { const float rs = __builtin_amdgcn_rsqf(wave_sum(lane < 32 ? ss[(size_t)row * 32 + lane] : 0.f) * pg8::INV_D + pg8::RMS_EPS);
        const bf16* xr = xbf + (size_t)row * DM + 8 * lane; float* orow = out + (size_t)row * DM + 8 * lane;
#pragma unroll
        for (int j = 0; j < 4; ++j) { const u32x4 v = *(const u32x4*)(xr + 512 * j);
            f32x4 a = (f32x4){bf_lo(v[0]), bf_hi(v[0]), bf_lo(v[1]), bf_hi(v[1])}, b = (f32x4){bf_lo(v[2]), bf_hi(v[2]), bf_lo(v[3]), bf_hi(v[3])};
            *(f32x4*)(orow + 512 * j) = a * rs * gv[2 * j]; *(f32x4*)(orow + 512 * j + 4) = b * rs * gv[2 * j + 1]; } }
}

#define SITE_IDS() int tid = (wave0_ << 6) | pg8::lane_id_fresh(); asm volatile("" : "+v"(tid)); const int lane = tid & 63, wave = __builtin_amdgcn_readfirstlane(tid >> 6); (void)lane; (void)wave
struct SkipOrder : pg8::StaticOrder { __device__ bool next(int i, pg8::Unit& u) const { if (!pg8::StaticOrder::next(i, u)) return false; if (u.pn >= 16) u.pn += 2; return true; } };
struct PairOrder : pg8::StaticOrder { __device__ bool next(int i, pg8::Unit& u) const { if (!pg8::StaticOrder::next(i, u)) return false; u.pn += 16; return true; } };
struct HotOrder : pg8::StaticOrder { bool hot;
    __device__ bool next(int i, pg8::Unit& u) const { if (!pg8::StaticOrder::next(i, u)) return false; if (hot) { u.pm = c & 7; u.pn = (c >> 3) & 1; } return true; }
};
struct RangeOrder : pg8::StaticOrder { int lo, hi;
    __device__ bool next(int i, pg8::Unit& u) const { if (lo + i >= hi) return false; return pg8::StaticOrder::next(lo + i, u); }
};
#ifndef DUP_ATT
#define DUP_ATT 1
#endif
#ifndef DUP_ATT1
#define DUP_ATT1 1
#endif
#ifndef DUP_BAR
#define DUP_BAR 1
#endif
#ifndef DUP_MP
#define DUP_MP 1
#endif
#ifndef DUP_GU
#define DUP_GU 1
#endif
#ifndef DUP_IN
#define DUP_IN 1
#endif
#ifndef DUP_DN
#define DUP_DN 1
#endif
#ifndef DUP_OUT
#define DUP_OUT 1
#endif
#ifndef GP_ALIGN
#define GP_ALIGN true
#endif
#ifndef GP_ALIGN8
#define GP_ALIGN8 true
#endif
#ifndef GP_SP28
#define GP_SP28 true
#endif
#ifndef GP_SP2
#define GP_SP2 true
#endif
#ifndef WGM_GU
#define WGM_GU 4
#endif
#ifndef WGM_GU8
#define WGM_GU8 4
#endif
#ifndef WGM_IN8
#define WGM_IN8 6
#endif
#ifndef WGM_N2K
#define WGM_N2K 4
#endif
#ifndef ROT_IN8
#define ROT_IN8 1
#endif
#ifndef PMX_DN
#define PMX_DN 4
#endif
#ifndef PMX_OUT
#define PMX_OUT 0
#endif
#ifndef DUP_PRO
#define DUP_PRO 1
#endif
struct Args { Ptrs p; int lo, hi; };
__global__ void __launch_bounds__(512, 2) fwd(Args args) {
    extern __shared__ __attribute__((aligned(16))) unsigned char lds_raw[];
    LAS unsigned char* lds = (LAS unsigned char*)lds_raw;
    const int G = gridDim.x;
    const Ptrs& P = args.p;
    unsigned char* ws = P.ws;
    volatile LAS unsigned* MISC = (volatile LAS unsigned*)(lds + MISC_OFF);
    if (threadIdx.x < 16) MISC[threadIdx.x] = 0u;
    __syncthreads();
    XcdBarrier bar = xcd_barrier_post((unsigned*)(ws + WS_CTL) + CW_BAR, MISC + 8);
    const int wave0_ = (int)bar.wv;
    const int lo = args.lo, hi = args.hi;
    int step = 0;
#define RUN_STEP (step >= lo && step < hi)
#define END_STEP do { if (step >= lo && step + 1 < hi) { for (int rep_ = 0; rep_ < DUP_BAR; ++rep_) xcd_barrier(bar); } ++step; } while (0)
    float* SS = (float*)(ws + WS_SS);
    bf16* XB = (bf16*)(ws + WS_XB); bf16* HB = (bf16*)(ws + WS_H); bf16* OG = (bf16*)(ws + WS_OG); bf16* ZB = (bf16*)(ws + WS_Z); bf16* MIX = (bf16*)(ws + WS_MIX);
    float* LSE = (float*)(ws + WS_LSE);

    if (RUN_STEP) { SITE_IDS(); for (int rep = 0; rep < DUP_PRO; ++rep) prologue(P, lds, tid, lane, wave, G, 0); }
    END_STEP;

    for (int c = 0; c < NCHUNK; ++c) {
        const size_t r0 = (size_t)c * TC;
        bf16* xb = XB + r0 * DM;
        for (int i = 0; i < 2 * DEPTH; ++i) {
            const int l = i >> 1, j = i & 1;
            const unsigned char* wl = ws + WS_W + (size_t)l * W_LAYER;
            const bool gu8 = ((I8GU_MASK >> i) & 1u) != 0u;
            if (I8GU_MASK != 0u && gu8) {
                if (RUN_STEP) { SITE_IDS(); quant_rows<false>(xb, ws + WS_XB8 + r0 * DM, (float*)(ws + WS_SA) + r0, nullptr, SS + ((size_t)(3 * l + 2 * j) * NTOK + r0) * 32, lane, wave, G); }
                END_STEP;
                if (RUN_STEP) { pg8::Gemm g{(const bf16*)(ws + WS_XB8 + r0 * DM), (const bf16*)(wl + (j ? WO_GU1 : WO_GU0)), TC, NGU, DM}; pg8::StaticOrder S; S.init(TC, NGU, G, (int)blockIdx.x, WGM_GU8);
                    pg8::EpiSwiGLUI8 E{HB, DFF, (const float*)ws, (unsigned)(WS_SA + r0 * 4), (unsigned)(WS_CM + (size_t)(CM_GU + i * NGU) * 4)};
                    for (int rep = 0; rep < DUP_GU8; ++rep) pg8::gemm_phase<pg8::EpiSwiGLUI8, pg8::StaticOrder, GP_ALIGN8, GP_SP28, 3>(lds, g, S, E, wave0_); }
                END_STEP;
            } else {
            if (RUN_STEP) { pg8::Gemm g{xb, (const bf16*)(wl + (j ? WO_GU1 : WO_GU0)), TC, NGU, DM}; pg8::StaticOrder S; S.init(TC, NGU, G, (int)blockIdx.x, WGM_GU);
                pg8::EpiSwiGLU E{HB, DFF, SS + ((size_t)(3 * l + 2 * j) * NTOK + r0) * 32};
#if defined(HOT_GU)
                HotOrder S2; S2.init(TC, NGU, G, (int)blockIdx.x);
                for (int rep = 0; rep < 2; ++rep) { S2.hot = (rep == 0); pg8::EpiSwiGLU E2{rep == 0 ? (bf16*)(ws + WS_END) : HB, DFF, SS + ((size_t)(3 * l + 2 * j) * NTOK + r0) * 32};
                  pg8::gemm_phase<pg8::EpiSwiGLU, HotOrder, GP_ALIGN, GP_SP2>(lds, g, S2, E2, wave0_); }
#else
#if defined(PROBE_SPLIT)
                { RangeOrder S3; S3.init(TC, NGU, G, (int)blockIdx.x, WGM_GU); S3.lo = 0; S3.hi = 5; pg8::gemm_phase<pg8::EpiSwiGLU, RangeOrder, GP_ALIGN, GP_SP2>(lds, g, S3, E, wave0_);
                  xcd_barrier(bar);
                  S3.lo = 5; S3.hi = 11; pg8::gemm_phase<pg8::EpiSwiGLU, RangeOrder, GP_ALIGN, GP_SP2>(lds, g, S3, E, wave0_); }
#else
                for (int rep = 0; rep < DUP_GU; ++rep) pg8::gemm_phase<pg8::EpiSwiGLU, pg8::StaticOrder, GP_ALIGN, GP_SP2>(lds, g, S, E, wave0_);
#endif
#endif
                }
            END_STEP;
            }
            if (RUN_STEP) { pg8::Gemm g{HB, (const bf16*)(wl + (j ? WO_D1 : WO_D0)), TC, DM, DFF}; pg8::StaticOrder S; S.init(TC, DM, G, (int)blockIdx.x, WGM_N2K, 1, PMX_DN);
                pg8::EpiResidual E{xb, SS + ((size_t)(3 * l + 2 * j + 1) * NTOK + r0) * 32, 0.5f, nullptr, xb};
#if defined(PROBE_DN)
                for (int rep = 0; rep < 2; ++rep) { pg8::EpiResidual E2 = E; if (rep == 0) { E2.xw = (bf16*)(ws + WS_END); E2.ssn = SS + (size_t)13 * NTOK * 32; E2.x8 = nullptr; } pg8::gemm_phase<pg8::EpiResidual, pg8::StaticOrder, GP_ALIGN, GP_SP2>(lds, g, S, E2, wave0_); }
#else
                pg8::gemm_phase<pg8::EpiResidual, pg8::StaticOrder, false, GP_SP2>(lds, g, S, E, wave0_);
#endif
                }
            END_STEP;
            if (j == 0) {
                if (RUN_STEP) { SITE_IDS(); quant_rows<true>(xb, ws + WS_XB8 + r0 * DM, (float*)(ws + WS_SA) + r0, (float*)(ws + WS_SR) + r0, SS + ((size_t)(3 * l + 1) * NTOK + r0) * 32, lane, wave, G); }
                END_STEP;
                if (RUN_STEP) {
                    { constexpr int NIN8 = I8_POOLIN ? INW : QKVW;
                      pg8::Gemm g{(const bf16*)(ws + WS_XB8 + r0 * DM), (const bf16*)(wl + WO_IN), TC, NIN8, DM}; SkipOrder S; S.init(TC, NIN8 - 512, G, (int)blockIdx.x, WGM_IN8, ROT_IN8);
                      pg8::EpiScaleI8 E{ZB, INW, (const float*)ws, (unsigned)(WS_SA + r0 * 4), (unsigned)(WS_CM + (size_t)(CM_IN + l * INW) * 4), QSCALE, 1.0f};
                      for (int rep = 0; rep < DUP_IN8; ++rep) pg8::gemm_phase<pg8::EpiScaleI8, SkipOrder, GP_ALIGN8, GP_SP28, 3>(lds, g, S, E, wave0_); }
                    }
                END_STEP;
                if (RUN_STEP) {
                    { pg8::Gemm g{(const bf16*)(ws + WS_XB8 + r0 * DM), (const bf16*)(wl + WO_IN), TC, QKVW, DM}; PairOrder S; S.init(TC, 512, G, (int)blockIdx.x, 4, 0);
                      pg8::EpiScaleI8 E{ZB, INW, (const float*)ws, (unsigned)(WS_SA + r0 * 4), (unsigned)(WS_CM + (size_t)(CM_IN + l * INW) * 4), QSCALE, 1.0f};
                      pg8::gemm_phase<pg8::EpiScaleI8, PairOrder, GP_ALIGN8, GP_SP28, 3>(lds, g, S, E, wave0_); }
                    if (!I8_POOLIN) { pg8::Gemm g{xb, (const bf16*)(wl + WO_INU), TC, POOLW, DM}; pg8::StaticOrder S; S.init(TC, POOLW, G, ((int)blockIdx.x + G / 2) % G);
                      pg8::EpiScaleBf16 E{ZB + QKVW, INW, (const float*)(ws + WS_SR) + r0, 1.0f, 1.0f, 0};
                      pg8::gemm_phase<pg8::EpiScaleBf16, pg8::StaticOrder, GP_ALIGN, GP_SP2, 2>(lds, g, S, E, wave0_); }
                    SITE_IDS(); const int n0 = G - G / 2, n1 = G / 2, bx = (int)blockIdx.x; const bool up = bx >= n0;
                    const int ci = (G % 16 == 0) ? (bx % 8) * (G / 16) + (bx / 8) % (G / 16) : (up ? bx - n0 : bx);
                    for (int rep = 0; rep < DUP_ATT; ++rep) attn_phase<0>(ZB, OG, LSE, MIX, (const float*)(ws + WS_LUT), lds, tid, lane, wave, up ? ATT_SPLIT + ci : ci, up ? n1 : n0, up ? 2304 : ATT_SPLIT); }
                END_STEP;
                if (RUN_STEP) { SITE_IDS(); const int vcu = (G % 8 == 0) ? ((int)blockIdx.x % 8) * (G / 8) + (int)blockIdx.x / 8 : (int)blockIdx.x;
                    for (int rep = 0; rep < DUP_ATT1; ++rep) attn_phase<1>(ZB, OG, LSE, MIX, (const float*)(ws + WS_LUT), lds, tid, lane, wave, vcu, G, 768); }
                if (RUN_STEP) { SITE_IDS();
                    for (int rep = 0; rep < DUP_MP; ++rep) pool_phase(ZB, MIX, (const bf16*)(ws + WS_WPT) + (size_t)l * 4 * 16384, P.pool_scale + l * POOLW, lane, wave, G); }
                END_STEP;
                if (RUN_STEP) { pg8::Gemm g{MIX, (const bf16*)(wl + WO_OUT), TC, DM, DM}; pg8::StaticOrder S; S.init(TC, DM, G, (int)blockIdx.x, WGM_N2K, 1, PMX_OUT);
                    pg8::EpiResidual E{xb, SS + ((size_t)(3 * l + 2) * NTOK + r0) * 32, 1.0f, nullptr, xb};
#if defined(PROBE_OUT)
                    for (int rep = 0; rep < 2; ++rep) { pg8::EpiResidual E2 = E; if (rep == 0) { E2.xw = (bf16*)(ws + WS_END); E2.ssn = SS + (size_t)13 * NTOK * 32; } pg8::gemm_phase<pg8::EpiResidual, pg8::StaticOrder, GP_ALIGN, GP_SP2>(lds, g, S, E2, wave0_); }
#else
                    pg8::gemm_phase<pg8::EpiResidual, pg8::StaticOrder, false, GP_SP2>(lds, g, S, E, wave0_);
#endif
                    }
                END_STEP;
            }
        }
    }
    if (RUN_STEP) { SITE_IDS(); final_norm(P.out, XB, SS + (size_t)12 * NTOK * 32, P.final_g, lane, wave, G); }
    END_STEP;
#undef RUN_STEP
#undef END_STEP
}

#ifndef MK_MULTI
#define MK_MULTI 0
#endif
extern "C" void kernel_launch(void* const* d_in, const int* in_sizes, int n_in, void* d_out, int out_size, void* d_ws, size_t ws_size, hipStream_t stream) {
    static int grid = 0;
    if (grid == 0) {
        if (n_in != 12 || out_size != NTOK * DM || ws_size < WS_END) { fprintf(stderr, "kernel_launch: unexpected problem (n_in %d, out %d, ws %zu)\n", n_in, out_size, ws_size); grid = -1; return; }
        int dev = 0, cus = 0, per_cu = 0;
        if (hipGetDevice(&dev) != hipSuccess || hipDeviceGetAttribute(&cus, hipDeviceAttributeMultiprocessorCount, dev) != hipSuccess) { grid = -1; return; }
        if (hipFuncSetAttribute((const void*)fwd, hipFuncAttributeMaxDynamicSharedMemorySize, LDS_BYTES) != hipSuccess) { fprintf(stderr, "kernel_launch: hipFuncSetAttribute failed\n"); grid = -1; return; }
        if (hipOccupancyMaxActiveBlocksPerMultiprocessor(&per_cu, (const void*)fwd, 512, LDS_BYTES) != hipSuccess || per_cu < 1) { fprintf(stderr, "kernel_launch: occupancy query says %d\n", per_cu); }
        (void)hipGetLastError();
        grid = cus;
    }
    if (grid < 0) return;
    (void)hipMemsetAsync((char*)d_ws + WS_CTL, 0, CTL_ZERO_BYTES, stream);
    Args a{};
    a.p.x_prompt = (const float*)d_in[0]; a.p.x_sample = (const float*)d_in[1]; a.p.norm_g = (const float*)d_in[2]; a.p.ffn_gate = (const float*)d_in[3];
    a.p.ffn_up = (const float*)d_in[4]; a.p.ffn_down = (const float*)d_in[5]; a.p.w_in = (const float*)d_in[6]; a.p.w_pool = (const float*)d_in[7];
    a.p.pool_scale = (const float*)d_in[8]; a.p.w_out = (const float*)d_in[9]; a.p.rel_bias = (const float*)d_in[10]; a.p.final_g = (const float*)d_in[11];
    a.p.out = (float*)d_out; a.p.ws = (unsigned char*)d_ws;
#if MK_MULTI
    for (int s = 0; s < NSTEPS; ++s) { a.lo = s; a.hi = s + 1; hipLaunchKernelGGL(fwd, dim3(grid), dim3(512), LDS_BYTES, stream, a); }
#else
    a.lo = 0; a.hi = 1 << 30;
    hipLaunchKernelGGL(fwd, dim3(grid), dim3(512), LDS_BYTES, stream, a);
#endif
}
```

```cpp
#include <hip/hip_runtime.h>
#include <cstdio>
#include <cstdint>
namespace pg8 {
#define PG8_LAS __attribute__((address_space(3)))
typedef unsigned short bf16_t;
typedef short bf16x8 __attribute__((ext_vector_type(8)));
typedef float f32x4 __attribute__((ext_vector_type(4)));
typedef unsigned u32x4 __attribute__((ext_vector_type(4)));
typedef int i32x8 __attribute__((ext_vector_type(8)));
typedef int i32x4_ __attribute__((ext_vector_type(4)));
constexpr int BM = 256, BK = 64, HALF = 128, HTB = HALF * BK * 2  , STAGE_BYTES = 8 * HTB, NXCD = 8;

__host__ __device__ __forceinline__ int lds_byte(int r, int c) { const int st = (r >> 4) * 2 + (c >> 5), rr = r & 15, cc = c & 31, ob = rr * 64 + cc * 2; return st * 1024 + (ob ^ (((ob >> 9) & 1) << 5)); }
__host__ __device__ __forceinline__ void stage_rc(int b, int& R, int& C) { const int st = b / 1024, sb = b % 1024, swz = sb ^ (((sb >> 9) & 1) << 5); R = (st >> 1) * 16 + swz / 64; C = (st & 1) * 32 + (swz % 64) / 2; }
__host__ __device__ __forceinline__ int perm32(int rho) { const int n = rho >> 4, i = rho & 15; return 8 * (i >> 2) + 4 * n + (i & 3); }

#ifndef PG8_B_BLOCKED
#define PG8_B_BLOCKED 1
#endif
__host__ __device__ __forceinline__ int inv_perm32(int w) { return 16 * ((w >> 2) & 1) + (((w >> 3) << 2) | (w & 3)); }
__host__ __device__ __forceinline__ size_t bblk_off(int n, int kbyte, int Kb) {
    const int slot = (n & ~31) + inv_perm32(n & 31), ob = (slot & 15) * 64 + (kbyte & 63);
    return ((size_t)(slot >> 4) * (size_t)(Kb >> 6) + (size_t)(kbyte >> 6)) * 1024 + (size_t)(ob ^ (((ob >> 9) & 1) << 5)); }
__device__ __forceinline__ int lane_id_fresh() { int l_; asm volatile("v_mbcnt_lo_u32_b32 %0, -1, 0\n\tv_mbcnt_hi_u32_b32 %0, -1, %0" : "=v"(l_)); return l_; }
struct Unit { int pm, pn; };
struct Gemm { const bf16_t* A; const bf16_t* Bt; int M, N, K; };

struct StaticOrder {
    int nM, nN, nwg, G, c, WGM, rot, pmx;
    __host__ __device__ void init(int M, int N, int G_, int c_, int wgm = 4, int rot_ = 1, int pmx_ = 0) { nM = M / BM; nN = N / BM; nwg = nM * nN; G = G_; c = c_; WGM = wgm; rot = rot_; pmx = pmx_; }
    __host__ __device__ bool next(int i, Unit& u) const {
        const long L = (long)i * G + c; if (L >= nwg) return false;
        int wgid = (int)L; { const int q = nwg / NXCD, r = nwg % NXCD, xcd = wgid % NXCD, off = wgid / NXCD; wgid = (xcd < r ? xcd * (q + 1) : r * (q + 1) + (xcd - r) * q) + off; }
        const int nig = WGM * nN, gid = wgid / nig, fm = gid * WGM, gsz = (nM - fm) < WGM ? (nM - fm) : WGM;
        u.pm = fm + ((wgid % nig) % gsz); u.pn = (wgid % nig) / gsz;
        if (rot) u.pn = (u.pn + (u.pm >> 3) * (nN / NXCD)) % nN;
        u.pm ^= pmx; return true;
    }
    __device__ __forceinline__ void a_ready(const Unit&) const {}
    __device__ __forceinline__ void done(const Unit&) const {}
};
__device__ __forceinline__ unsigned cvt_pk_bf16(float lo, float hi) { unsigned r; asm volatile("v_cvt_pk_bf16_f32 %0, %1, %2" : "=v"(r) : "v"(lo), "v"(hi)); return r; }
typedef float f32x2 __attribute__((ext_vector_type(2)));
typedef unsigned u32x2_ __attribute__((ext_vector_type(2)));
constexpr float RMS_EPS = 1e-6f;
constexpr float INV_D = 1.0f / 2048.0f;
__device__ __forceinline__ float row_rstd(const float* ssp, int row, int fq) {
    const f32x4 a = *(const f32x4*)(ssp + (size_t)row * 32 + 8 * fq), b = *(const f32x4*)(ssp + (size_t)row * 32 + 8 * fq + 4);
    float s = ((a[0] + a[1]) + (a[2] + a[3])) + ((b[0] + b[1]) + (b[2] + b[3]));
    s += __shfl_xor(s, 16); s += __shfl_xor(s, 32);
    return __builtin_amdgcn_rsqf(s * INV_D + RMS_EPS);
}
__device__ __forceinline__ float row_msq(const float* ssp, int row, int fq) {
    const f32x4 a = *(const f32x4*)(ssp + (size_t)row * 32 + 8 * fq), b = *(const f32x4*)(ssp + (size_t)row * 32 + 8 * fq + 4);
    float s = ((a[0] + a[1]) + (a[2] + a[3])) + ((b[0] + b[1]) + (b[2] + b[3]));
    s += __shfl_xor(s, 16); s += __shfl_xor(s, 32);
    return s * INV_D + RMS_EPS;
}
struct EpiSwiGLU {
    static constexpr bool PERM = true, AFTER_DRAIN = false, LDS_SCALES = false;
    bf16_t* H; int ldh; const float* ss;
    __device__ __forceinline__ void operator()(const f32x4 (&acc)[2][2][4][2], const Unit& u, int wr, int wc, int fr, int fq) const {
        const int row0 = u.pm * BM + wr * 64 + fr, col0 = u.pn * HALF + wc * 32 + 8 * fq;
#ifdef DUP_EPI
        for (int rep_ = 0; rep_ < DUP_EPI; ++rep_)
#endif
#pragma unroll
        for (int ai = 0; ai < 2; ++ai)
#pragma unroll
            for (int m = 0; m < 4; ++m) { const int row = row0 + ai * HALF + m * 16; const float v = row_msq(ss, row, fq), c1 = -1.4426950408889634f * __builtin_amdgcn_rsqf(v);
                const f32x2 vv = (f32x2){v, v}, cc = (f32x2){c1, c1};
                unsigned w[4]; f32x2 g[4], up[4], e[4], r[4];
#pragma unroll
                for (int q = 0; q < 4; ++q) { g[q] = (f32x2){acc[ai][0][m][q >> 1][2 * (q & 1)], acc[ai][0][m][q >> 1][2 * (q & 1) + 1]}; up[q] = (f32x2){acc[ai][1][m][q >> 1][2 * (q & 1)], acc[ai][1][m][q >> 1][2 * (q & 1) + 1]}; }
#pragma unroll
                for (int q = 0; q < 4; ++q) { const f32x2 ea = g[q] * cc; e[q].x = __builtin_amdgcn_exp2f(ea.x); e[q].y = __builtin_amdgcn_exp2f(ea.y); }
#pragma unroll
                for (int q = 0; q < 4; ++q) { const f32x2 den = e[q] * vv + vv; r[q].x = __builtin_amdgcn_rcpf(den.x); r[q].y = __builtin_amdgcn_rcpf(den.y); }
#pragma unroll
                for (int q = 0; q < 4; ++q) { const f32x2 hv = (g[q] * up[q]) * r[q]; w[q] = cvt_pk_bf16(hv.x, hv.y); }
                u32x4 o; o.x = w[0]; o.y = w[1]; o.z = w[2]; o.w = w[3];
                *(u32x4*)(H + (size_t)row * ldh + col0) = o; }
    }
};
struct EpiScaleBf16 {
    static constexpr bool PERM = true, AFTER_DRAIN = false, LDS_SCALES = false;
    bf16_t* Z; int ldz; const float* rsd; float csq, cso; int qtiles;
    __device__ __forceinline__ void operator()(const f32x4 (&acc)[2][2][4][2], const Unit& u, int wr, int wc, int fr, int fq) const {
        const int row0 = u.pm * BM + wr * 64 + fr, col0 = u.pn * BM + wc * 32 + 8 * fq;
        const float cs = (qtiles && (u.pn % 18) < 6) ? csq : cso;
#pragma unroll
        for (int ai = 0; ai < 2; ++ai)
#pragma unroll
            for (int m = 0; m < 4; ++m) { const int row = row0 + ai * HALF + m * 16; const float rs = rsd[row] * cs;
#pragma unroll
                for (int bj = 0; bj < 2; ++bj) { const f32x4 v0 = acc[ai][bj][m][0] * rs, v1 = acc[ai][bj][m][1] * rs;
                    u32x4 o; o.x = cvt_pk_bf16(v0[0], v0[1]); o.y = cvt_pk_bf16(v0[2], v0[3]); o.z = cvt_pk_bf16(v1[0], v1[1]); o.w = cvt_pk_bf16(v1[2], v1[3]);
                    *(u32x4*)(Z + (size_t)row * ldz + col0 + bj * HALF) = o; } }
    }
};
__device__ __forceinline__ f32x4 i2f4(f32x4 a) { const i32x4_ i = __builtin_bit_cast(i32x4_, a); return (f32x4){(float)i[0], (float)i[1], (float)i[2], (float)i[3]}; }
struct EpiScaleI8 {
    static constexpr bool PERM = true, AFTER_DRAIN = false, LDS_SCALES = true;
    bf16_t* Z; int ldz; const float* sbase; unsigned row_off, col_off; float csq, cso;
    __device__ __forceinline__ void operator()(const f32x4 (&acc)[2][2][4][2], const Unit& u, int wr, int wc, int fr, int fq, const PG8_LAS float* lsc) const {
        const int row0 = u.pm * BM + wr * 64 + fr, col0 = u.pn * BM + wc * 32 + 8 * fq;
        const float cs = ((u.pn < 54 && (u.pn % 18) < 6) ? csq : cso) * (1.0f / 127.0f);
        f32x4 cb[2][2];
#pragma unroll
        for (int bj = 0; bj < 2; ++bj)
#pragma unroll
            for (int n = 0; n < 2; ++n) cb[bj][n] = *(const PG8_LAS f32x4*)(lsc + 256 + wc * 32 + 8 * fq + bj * HALF + 4 * n) * cs;
#pragma unroll
        for (int ai = 0; ai < 2; ++ai)
#pragma unroll
            for (int m = 0; m < 4; ++m) { const int row = row0 + ai * HALF + m * 16; const float rs = lsc[ai * HALF + wr * 64 + m * 16 + fr];
#pragma unroll
                for (int bj = 0; bj < 2; ++bj) { const f32x4 v0 = i2f4(acc[ai][bj][m][0]) * cb[bj][0] * rs, v1 = i2f4(acc[ai][bj][m][1]) * cb[bj][1] * rs;
                    u32x4 o; o.x = cvt_pk_bf16(v0[0], v0[1]); o.y = cvt_pk_bf16(v0[2], v0[3]); o.z = cvt_pk_bf16(v1[0], v1[1]); o.w = cvt_pk_bf16(v1[2], v1[3]);
                    *(u32x4*)(Z + (size_t)row * ldz + col0 + bj * HALF) = o; } }
    }
};
struct EpiSwiGLUI8 {
    static constexpr bool PERM = true, AFTER_DRAIN = false, LDS_SCALES = true;
    bf16_t* H; int ldh; const float* sbase; unsigned row_off, col_off;
    __device__ __forceinline__ void operator()(const f32x4 (&acc)[2][2][4][2], const Unit& u, int wr, int wc, int fr, int fq, const PG8_LAS float* lsc) const {
        const int row0 = u.pm * BM + wr * 64 + fr, col0 = u.pn * HALF + wc * 32 + 8 * fq;
        f32x2 cg[4], cu[4];
        { const PG8_LAS float* lc = lsc + 256 + wc * 32 + 8 * fq;
          const f32x4 g0 = *(const PG8_LAS f32x4*)(lc), g1 = *(const PG8_LAS f32x4*)(lc + 4), u0 = *(const PG8_LAS f32x4*)(lc + HALF), u1 = *(const PG8_LAS f32x4*)(lc + HALF + 4);
          cg[0] = (f32x2){g0[0], g0[1]} * (1.0f / 127.0f); cg[1] = (f32x2){g0[2], g0[3]} * (1.0f / 127.0f); cg[2] = (f32x2){g1[0], g1[1]} * (1.0f / 127.0f); cg[3] = (f32x2){g1[2], g1[3]} * (1.0f / 127.0f);
          cu[0] = (f32x2){u0[0], u0[1]} * (1.0f / 127.0f); cu[1] = (f32x2){u0[2], u0[3]} * (1.0f / 127.0f); cu[2] = (f32x2){u1[0], u1[1]} * (1.0f / 127.0f); cu[3] = (f32x2){u1[2], u1[3]} * (1.0f / 127.0f); }
#pragma unroll
        for (int ai = 0; ai < 2; ++ai)
#pragma unroll
            for (int m = 0; m < 4; ++m) { const int row = row0 + ai * HALF + m * 16; const float a = lsc[ai * HALF + wr * 64 + m * 16 + fr];
                const f32x2 aa = (f32x2){a, a}, ae = (f32x2){a * -1.4426950408889634f, a * -1.4426950408889634f};
                unsigned w[4]; f32x2 gf[4], uf[4], G[4], e[4], r[4];
#pragma unroll
                for (int q = 0; q < 4; ++q) { const i32x4_ gi = __builtin_bit_cast(i32x4_, acc[ai][0][m][q >> 1]), ui = __builtin_bit_cast(i32x4_, acc[ai][1][m][q >> 1]);
                    gf[q] = (f32x2){(float)gi[2 * (q & 1)], (float)gi[2 * (q & 1) + 1]} * cg[q]; uf[q] = (f32x2){(float)ui[2 * (q & 1)], (float)ui[2 * (q & 1) + 1]} * cu[q]; }
#pragma unroll
                for (int q = 0; q < 4; ++q) { const f32x2 ea = gf[q] * ae; e[q].x = __builtin_amdgcn_exp2f(ea.x); e[q].y = __builtin_amdgcn_exp2f(ea.y); G[q] = gf[q] * aa; }
#pragma unroll
                for (int q = 0; q < 4; ++q) { const f32x2 den = e[q] + 1.0f; r[q].x = __builtin_amdgcn_rcpf(den.x); r[q].y = __builtin_amdgcn_rcpf(den.y); }
#pragma unroll
                for (int q = 0; q < 4; ++q) { const f32x2 hv = (G[q] * (uf[q] * aa)) * r[q]; w[q] = cvt_pk_bf16(hv.x, hv.y); }
                u32x4 o; o.x = w[0]; o.y = w[1]; o.z = w[2]; o.w = w[3];
                *(u32x4*)(H + (size_t)row * ldh + col0) = o; }
    }
};
struct EpiResidual {
    static constexpr bool PERM = true, AFTER_DRAIN = false, LDS_SCALES = false;
    bf16_t* xb; float* ssn; float sc; unsigned char* x8; bf16_t* xw;
    __device__ __forceinline__ void operator()(const f32x4 (&acc)[2][2][4][2], const Unit& u, int wr, int wc, int fr, int fq) const {
        const int row0 = u.pm * BM + wr * 64 + fr, col0 = u.pn * BM + wc * 32 + 8 * fq;
        u32x4 xa[2][4][2];
#pragma unroll
        for (int ai = 0; ai < 2; ++ai)
#pragma unroll
            for (int m = 0; m < 4; ++m) { const size_t off = (size_t)(row0 + ai * HALF + m * 16) * 2048 + col0;
#pragma unroll
                for (int bj = 0; bj < 2; ++bj) xa[ai][m][bj] = *(const u32x4*)(xb + off + bj * HALF); }
        asm volatile("" ::: "memory");
#pragma unroll
        for (int ai = 0; ai < 2; ++ai) {
            float qq[4];
#pragma unroll
            for (int m = 0; m < 4; ++m) { const int row = row0 + ai * HALF + m * 16; const size_t off = (size_t)row * 2048 + col0; float q = 0.f;
#pragma unroll
                for (int bj = 0; bj < 2; ++bj) { const u32x4 xo = xa[ai][m][bj]; const f32x4 d0 = acc[ai][bj][m][0] * sc, d1 = acc[ai][bj][m][1] * sc;
                    const float a0 = __uint_as_float(xo[0] << 16) + d0[0], a1 = __uint_as_float(xo[0] & 0xffff0000u) + d0[1], a2 = __uint_as_float(xo[1] << 16) + d0[2], a3 = __uint_as_float(xo[1] & 0xffff0000u) + d0[3];
                    const float b0 = __uint_as_float(xo[2] << 16) + d1[0], b1 = __uint_as_float(xo[2] & 0xffff0000u) + d1[1], b2 = __uint_as_float(xo[3] << 16) + d1[2], b3 = __uint_as_float(xo[3] & 0xffff0000u) + d1[3];
                    u32x4 o; o.x = cvt_pk_bf16(a0, a1); o.y = cvt_pk_bf16(a2, a3); o.z = cvt_pk_bf16(b0, b1); o.w = cvt_pk_bf16(b2, b3);
                    *(u32x4*)(xw + off + bj * HALF) = o;
                    if (x8) { u32x2_ e; e.x = __builtin_amdgcn_cvt_pk_fp8_f32(a0, a1, 0, false); e.x = __builtin_amdgcn_cvt_pk_fp8_f32(a2, a3, e.x, true);
                        e.y = __builtin_amdgcn_cvt_pk_fp8_f32(b0, b1, 0, false); e.y = __builtin_amdgcn_cvt_pk_fp8_f32(b2, b3, e.y, true); *(u32x2_*)(x8 + off + bj * HALF) = e; }
                    q += (a0 * a0 + a1 * a1) + (a2 * a2 + a3 * a3) + (b0 * b0 + b1 * b1) + (b2 * b2 + b3 * b3); }
                q += __shfl_xor(q, 16); q += __shfl_xor(q, 32); qq[m] = q; }
            { const float qs = (fq == 0) ? qq[0] : (fq == 1) ? qq[1] : (fq == 2) ? qq[2] : qq[3];
              ssn[(size_t)(row0 + ai * HALF + fq * 16) * 32 + u.pn * 4 + wc] = qs; }
            asm volatile("" ::: "memory"); }
    }
};
template <class Epi, class Sched, bool ALIGN_EPI = false, bool SP2 = false, int ESZ = 2>
__device__ __forceinline__ void gemm_phase(PG8_LAS unsigned char* lds, const Gemm g, const Sched& S, const Epi& E, int wv  ) {
    constexpr bool B_BLOCKED = (PG8_B_BLOCKED != 0) && Epi::PERM;
    int tid_ = (wv << 6) | lane_id_fresh(); asm volatile("" : "+v"(tid_));
    const int tid = tid_, wid = __builtin_amdgcn_readfirstlane(tid >> 6), lane = tid & 63, wr = wid >> 2, wc = wid & 3, fr = lane & 15, fq = lane >> 4;
    const int K = g.K, Kb = K * (ESZ == 2 ? 2 : 1)  , nt = Kb / (BK * 2);
    unsigned voffA[2], voffB[2];
#pragma unroll
    for (int i = 0; i < 2; ++i) { int R, C; stage_rc(tid * 16 + i * 8192, R, C); const int Rb = Epi::PERM ? ((R & ~31) + perm32(R & 31)) : R;
        voffA[i] = (unsigned)(R * Kb + C * 2);
        if constexpr (B_BLOCKED) { const int b_ = tid * 16 + i * 8192, st_ = b_ >> 10; (void)Rb; voffB[i] = (unsigned)(((st_ >> 1) * (Kb >> 6) + (st_ & 1)) * 1024 + (b_ & 1023)); }
        else voffB[i] = (unsigned)(Rb * Kb + C * 2); }
    const unsigned kstep = (unsigned)(BK * 2);
    const unsigned kstepB = B_BLOCKED ? 2048u : kstep;
    const unsigned hstep = (unsigned)HALF * (unsigned)Kb;
    const unsigned tstep = 2u * hstep;
    const unsigned ldsw = (unsigned)wid * 1024u;
    const int aoff = lds_byte(wr * 64 + fr, fq * 8), boff = lds_byte(wc * 32 + fr, fq * 8);
#define PG8_SA(b, h) (((b) * 2 + (h)) * HTB)
#define PG8_SB(b, h) ((4 + (b) * 2 + (h)) * HTB)
#define PG8_STAGE(bufoff, rsrc, soff, voff) do { _Pragma("unroll") for (int _i = 0; _i < 2; ++_i) \
        __builtin_amdgcn_raw_ptr_buffer_load_lds((rsrc), (PG8_LAS void*)(lds + (bufoff) + ldsw + _i * 8192), 16, (int)(voff)[_i], (int)(soff), 0, 0); } while (0)
#define PG8_LDA(dst, b, h) do { _Pragma("unroll") for (int m = 0; m < 4; ++m) _Pragma("unroll") for (int k = 0; k < 2; ++k) dst[m][k] = *(const PG8_LAS bf16x8*)(lds + PG8_SA(b, h) + aoff + m * 2048 + k * 1024); } while (0)
#define PG8_LDB(dst, b, h) do { _Pragma("unroll") for (int n = 0; n < 2; ++n) _Pragma("unroll") for (int k = 0; k < 2; ++k) dst[n][k] = *(const PG8_LAS bf16x8*)(lds + PG8_SB(b, h) + boff + n * 2048 + k * 1024); } while (0)
#define PG8_MMA(ai, bj, At, Bt) do { __builtin_amdgcn_s_setprio(1); \
        if constexpr (ESZ == 2) { _Pragma("unroll") for (int m = 0; m < 4; ++m) _Pragma("unroll") for (int n = 0; n < 2; ++n) _Pragma("unroll") for (int k = 0; k < 2; ++k) \
            acc[ai][bj][m][n] = __builtin_amdgcn_mfma_f32_16x16x32_bf16(Bt[n][k], At[m][k], acc[ai][bj][m][n], 0, 0, 0); } \
        else if constexpr (ESZ == 3) { _Pragma("unroll") for (int m = 0; m < 4; ++m) _Pragma("unroll") for (int n = 0; n < 2; ++n) _Pragma("unroll") for (int k = 0; k < 2; ++k) \
            acc[ai][bj][m][n] = __builtin_bit_cast(f32x4, __builtin_amdgcn_mfma_i32_16x16x64_i8(__builtin_bit_cast(i32x4_, Bt[n][k]), __builtin_bit_cast(i32x4_, At[m][k]), __builtin_bit_cast(i32x4_, acc[ai][bj][m][n]), 0, 0, 0)); } \
        else { _Pragma("unroll") for (int m = 0; m < 4; ++m) _Pragma("unroll") for (int n = 0; n < 2; ++n) { \
            const i32x8 b8_ = __builtin_shufflevector(__builtin_bit_cast(i32x4_, Bt[n][0]), __builtin_bit_cast(i32x4_, Bt[n][1]), 0, 1, 2, 3, 4, 5, 6, 7); \
            const i32x8 a8_ = __builtin_shufflevector(__builtin_bit_cast(i32x4_, At[m][0]), __builtin_bit_cast(i32x4_, At[m][1]), 0, 1, 2, 3, 4, 5, 6, 7); \
            asm volatile("v_mfma_scale_f32_16x16x128_f8f6f4 %0, %1, %2, %0, %3, %3 op_sel_hi:[0,0,0]" : "+v"(acc[ai][bj][m][n]) : "v"(b8_), "v"(a8_), "v"(one8_)); } } \
        __builtin_amdgcn_s_setprio(0); } while (0)
#define PG8_WAIT_V(n) asm volatile("s_waitcnt vmcnt(" #n ")" ::: "memory")
#define PG8_WAIT_L(n) asm volatile("s_waitcnt lgkmcnt(" #n ")" ::: "memory")
#define PG8_BAR __builtin_amdgcn_s_barrier()
#define PG8_SCHED __builtin_amdgcn_sched_barrier(0)
    const int one8_ = 0x7f7f7f7f;
    Unit cur, nxt; int ui = 0;
    if (!S.next(0, cur)) return;
    f32x4 acc[2][2][4][2];
#pragma unroll
    for (int a = 0; a < 2; ++a)
#pragma unroll
        for (int b = 0; b < 2; ++b)
#pragma unroll
            for (int m = 0; m < 4; ++m)
#pragma unroll
                for (int n = 0; n < 2; ++n) { typedef double f64x2_ __attribute__((ext_vector_type(2))); f64x2_ z_; asm volatile("v_mov_b64 %0, 0" : "=v"(z_.x)); asm volatile("v_mov_b64 %0, 0" : "=v"(z_.y)); acc[a][b][m][n] = __builtin_bit_cast(f32x4, z_); }
    bf16x8 At[4][2], B0[2][2], B1[2][2];
    const __amdgpu_buffer_rsrc_t rA = __builtin_amdgcn_make_buffer_rsrc((void*)g.A, 0, (int)((unsigned)g.M * (unsigned)Kb), 0x00020000), rB = __builtin_amdgcn_make_buffer_rsrc((void*)g.Bt, 0, (int)((unsigned)g.N * (unsigned)Kb), 0x00020000);
    unsigned cA = (unsigned)cur.pm * tstep, cB = (unsigned)cur.pn * tstep;
    __amdgpu_buffer_rsrc_t rS = rA; unsigned voffS = 0;
    if constexpr (Epi::LDS_SCALES) { rS = __builtin_amdgcn_make_buffer_rsrc((void*)E.sbase, 0, 1 << 24, 0x00020000); voffS = (unsigned)(lane * 4 + (wid & 3) * 256); }
    S.a_ready(cur);
    if constexpr (SP2) {
        PG8_STAGE(PG8_SB(0, 0), rB, cB, voffB); PG8_STAGE(PG8_SB(0, 1), rB, cB + hstep, voffB); PG8_STAGE(PG8_SA(0, 0), rA, cA, voffA); PG8_STAGE(PG8_SA(0, 1), rA, cA + hstep, voffA);
        if (wr == 1) PG8_BAR;
        PG8_WAIT_V(2); PG8_BAR;
        PG8_STAGE(PG8_SB(1, 0), rB, cB + kstepB, voffB); PG8_STAGE(PG8_SA(1, 0), rA, cA + kstep, voffA); PG8_STAGE(PG8_SB(1, 1), rB, cB + hstep + kstepB, voffB);
        PG8_WAIT_V(6); PG8_BAR;
    } else {
        PG8_STAGE(PG8_SB(0, 0), rB, cB, voffB); PG8_STAGE(PG8_SA(0, 0), rA, cA, voffA); PG8_STAGE(PG8_SB(0, 1), rB, cB + hstep, voffB); PG8_STAGE(PG8_SA(0, 1), rA, cA + hstep, voffA);
        if (wr == 1) PG8_BAR;
        PG8_WAIT_V(4); PG8_BAR;
        PG8_STAGE(PG8_SB(1, 0), rB, cB + kstepB, voffB); PG8_STAGE(PG8_SA(1, 0), rA, cA + kstep, voffA); PG8_STAGE(PG8_SB(1, 1), rB, cB + hstep + kstepB, voffB);
        PG8_WAIT_V(6); PG8_BAR;
    }
    for (;;) {
        const bool has_next = S.next(ui + 1, nxt);
        const unsigned nA = has_next ? (unsigned)nxt.pm * tstep : cA, nB = has_next ? (unsigned)nxt.pn * tstep : cB;
        for (int t = 0; t < nt; t += 2) {
            const bool last = (t == nt - 2);
            const unsigned a1 = cA + (unsigned)(t + 1) * kstep;
            const unsigned a2 = last ? nA : cA + (unsigned)(t + 2) * kstep, b2 = last ? nB : cB + (unsigned)(t + 2) * kstepB;
            const unsigned a3 = a2 + kstep, b3 = b2 + kstepB;
            if (last && has_next) S.a_ready(nxt);
            if constexpr (Epi::LDS_SCALES) { if (last) {
                const unsigned so_ = (wid < 4) ? E.row_off + (unsigned)cur.pm * 1024u : E.col_off + (unsigned)cur.pn * 1024u;
                __builtin_amdgcn_raw_ptr_buffer_load_lds(rS, (PG8_LAS void*)(lds + 131072 + wid * 256), 4, (int)voffS, (int)so_, 0, 0); } }
            if constexpr (SP2) {
            PG8_LDB(B0, 0, 0); PG8_LDB(B1, 0, 1); PG8_SCHED; PG8_LDA(At, 0, 0); PG8_STAGE(PG8_SA(1, 1), rA, a1 + hstep, voffA);
            PG8_WAIT_V(8); PG8_WAIT_L(0); PG8_BAR; PG8_MMA(0, 0, At, B0); PG8_MMA(0, 1, At, B1); PG8_BAR; PG8_SCHED;
            PG8_LDA(At, 0, 1); PG8_STAGE(PG8_SB(0, 0), rB, b2, voffB); PG8_STAGE(PG8_SB(0, 1), rB, b2 + hstep, voffB); PG8_STAGE(PG8_SA(0, 0), rA, a2, voffA);
            PG8_WAIT_V(8); PG8_WAIT_L(0); PG8_BAR; PG8_MMA(1, 0, At, B0); PG8_MMA(1, 1, At, B1); PG8_BAR; PG8_SCHED;
            PG8_LDB(B0, 1, 0); PG8_LDB(B1, 1, 1); PG8_SCHED; PG8_LDA(At, 1, 0); PG8_STAGE(PG8_SA(0, 1), rA, a2 + hstep, voffA);
            PG8_WAIT_V(8); PG8_WAIT_L(0); PG8_BAR; PG8_MMA(0, 0, At, B0); PG8_MMA(0, 1, At, B1); PG8_BAR; PG8_SCHED;
            PG8_LDA(At, 1, 1); PG8_STAGE(PG8_SB(1, 0), rB, b3, voffB); PG8_STAGE(PG8_SB(1, 1), rB, b3 + hstep, voffB); PG8_STAGE(PG8_SA(1, 0), rA, a3, voffA);
            PG8_WAIT_V(8); PG8_WAIT_L(0); PG8_BAR; PG8_MMA(1, 0, At, B0); PG8_MMA(1, 1, At, B1); PG8_BAR; PG8_SCHED;
            } else {
            PG8_LDB(B0, 0, 0); PG8_SCHED; PG8_LDA(At, 0, 0); PG8_STAGE(PG8_SA(1, 1), rA, a1 + hstep, voffA);
            PG8_WAIT_L(8); PG8_BAR; PG8_WAIT_L(0); PG8_MMA(0, 0, At, B0); PG8_BAR; PG8_SCHED;
            PG8_LDB(B1, 0, 1); PG8_STAGE(PG8_SB(0, 0), rB, b2, voffB);
            PG8_BAR; PG8_WAIT_L(0); PG8_MMA(0, 1, At, B1); PG8_BAR;
            PG8_LDA(At, 0, 1); PG8_STAGE(PG8_SA(0, 0), rA, a2, voffA);
            PG8_BAR; PG8_WAIT_L(0); PG8_MMA(1, 0, At, B0); PG8_BAR; PG8_SCHED;
            PG8_STAGE(PG8_SB(0, 1), rB, b2 + hstep, voffB);
            PG8_WAIT_V(6); PG8_BAR; PG8_MMA(1, 1, At, B1); PG8_BAR;
            PG8_LDB(B0, 1, 0); PG8_SCHED; PG8_LDA(At, 1, 0); PG8_STAGE(PG8_SA(0, 1), rA, a2 + hstep, voffA);
            PG8_WAIT_L(8); PG8_BAR; PG8_WAIT_L(0); PG8_MMA(0, 0, At, B0); PG8_BAR; PG8_SCHED;
            PG8_LDB(B1, 1, 1); PG8_STAGE(PG8_SB(1, 0), rB, b3, voffB);
            PG8_BAR; PG8_WAIT_L(0); PG8_MMA(0, 1, At, B1); PG8_BAR;
            PG8_LDA(At, 1, 1); PG8_STAGE(PG8_SA(1, 0), rA, a3, voffA);
            PG8_BAR; PG8_WAIT_L(0); PG8_MMA(1, 0, At, B0); PG8_BAR; PG8_SCHED;
            PG8_STAGE(PG8_SB(1, 1), rB, b3 + hstep, voffB);
            PG8_WAIT_V(6); PG8_BAR; PG8_MMA(1, 1, At, B1); PG8_BAR;
            }
        }
        if constexpr (ESZ == 1) asm volatile("s_nop 15\n\ts_nop 15" ::: "memory");
        if constexpr (ALIGN_EPI) { if (wr == 0) PG8_BAR; }
        if constexpr (!Epi::AFTER_DRAIN) { Unit ue_ = cur; asm volatile("" : "+s"(ue_.pm), "+s"(ue_.pn));
            if constexpr (Epi::LDS_SCALES) E(acc, ue_, wr, wc, fr, fq, (const PG8_LAS float*)(lds + 131072)); else E(acc, ue_, wr, wc, fr, fq); S.done(cur); }
        if (!has_next) break;
#pragma unroll
        for (int a = 0; a < 2; ++a)
#pragma unroll
            for (int b = 0; b < 2; ++b)
#pragma unroll
                for (int m = 0; m < 4; ++m)
#pragma unroll
                    for (int n = 0; n < 2; ++n) { typedef double f64x2_ __attribute__((ext_vector_type(2))); f64x2_ z_; asm volatile("v_mov_b64 %0, 0" : "=v"(z_.x)); asm volatile("v_mov_b64 %0, 0" : "=v"(z_.y)); acc[a][b][m][n] = __builtin_bit_cast(f32x4, z_); }
        cur = nxt; cA = nA; cB = nB; ++ui;
        if constexpr (ALIGN_EPI) { if (wr == 1) PG8_BAR; }
    }
    PG8_WAIT_V(0);
    if constexpr (!ALIGN_EPI) { if (wr == 0) PG8_BAR; }
    PG8_BAR;
    if constexpr (Epi::AFTER_DRAIN) { E.fused(acc, cur, wr, wc, fr, fq, lds, wid, lane); S.done(cur); }
#undef PG8_SA
#undef PG8_SB
#undef PG8_STAGE
#undef PG8_LDA
#undef PG8_LDB
#undef PG8_MMA
#undef PG8_WAIT_V
#undef PG8_WAIT_L
#undef PG8_BAR
#undef PG8_SCHED
}
}
#define LAS __attribute__((address_space(3)))
#define XB_TMO      128
#define XB_XCNT(j)  (256  + 64 * (j))
#define XB_XSUB(j)  (1280 + 64 * (j))
#define XB_XGEN(j)  (2304 + 64 * (j))
#define XB_TOP      3328
#define XB_TOPGEN   3392
#define XCD_BAR_WORDS 3456
#define XB_SPIN_CAP (1u << 18)

__device__ __forceinline__ unsigned xb_ld(unsigned* p)              { return __hip_atomic_load(p, __ATOMIC_RELAXED, __HIP_MEMORY_SCOPE_AGENT); }
__device__ __forceinline__ unsigned xb_add(unsigned* p, unsigned v) { return __hip_atomic_fetch_add(p, v, __ATOMIC_RELAXED, __HIP_MEMORY_SCOPE_AGENT); }
__device__ __forceinline__ unsigned xb_xcc_id() { return (unsigned)__builtin_amdgcn_s_getreg((3 << 11) | 20) & 0xFu; }
#define XB_SPIN(cond, bar) do { unsigned _sp = 0; while (cond) { __builtin_amdgcn_s_sleep(1); \
    if ((++_sp & 255u) == 0u) { if (xb_ld(&(bar)[XB_TMO])) break; if (_sp > XB_SPIN_CAP) { atomicAdd(&(bar)[XB_TMO], 1u); break; } } } } while (0)

struct XcdBarrier {
    unsigned* bar; unsigned x; unsigned wv;
    volatile LAS unsigned* st;
};

__device__ __forceinline__ unsigned xb_lane() { return (unsigned)pg8::lane_id_fresh(); }
__device__ __forceinline__ XcdBarrier xcd_barrier_post(unsigned* bar, volatile LAS unsigned* st) {
    XcdBarrier b; b.bar = bar; b.x = xb_xcc_id(); b.st = st; b.wv = (unsigned)__builtin_amdgcn_readfirstlane((int)(threadIdx.x >> 6));
    if (threadIdx.x == 0) (void)xb_add(&bar[XB_XCNT(b.x)], 1u);
    return b;
}
__device__ __forceinline__ void xcd_barrier_complete(unsigned* bar, unsigned x, unsigned& nloc, unsigned& nx) {
    const unsigned G = gridDim.x * gridDim.y * gridDim.z;
    unsigned sum, cnt, mine, sp = 0u;
    for (;;) {
        sum = 0u; cnt = 0u; mine = 0u;
#pragma unroll
        for (unsigned j = 0; j < 16; ++j) { const unsigned c = xb_ld(&bar[XB_XCNT(j)]); sum += c; cnt += (c > 0u) ? 1u : 0u; mine = (j == x) ? c : mine; }
        if (sum == G) break;
        __builtin_amdgcn_s_sleep(1);
        if ((++sp & 255u) == 0u) { if (xb_ld(&bar[XB_TMO])) break; if (sp > XB_SPIN_CAP) { atomicAdd(&bar[XB_TMO], 1u); break; } }
    }
    nloc = mine > 0u ? mine : 1u; nx = cnt > 0u ? cnt : 1u;
}

__device__ __forceinline__ void xcd_barrier(const XcdBarrier& b) {
    asm volatile("s_waitcnt vmcnt(0)" ::: "memory");
    __syncthreads();
    if (b.wv == 0u && xb_lane() == 0u) {
        unsigned* bar = b.bar;
        __builtin_amdgcn_s_waitcnt(0);
        unsigned nloc = b.st[0], nx = b.st[1];
        if (nloc == 0u) { xcd_barrier_complete(bar, b.x, nloc, nx); b.st[0] = nloc; b.st[1] = nx; }
        const unsigned old = xb_add(&bar[XB_XSUB(b.x)], 1u);
        const unsigned gen = old / nloc;
        if (old + 1u == (gen + 1u) * nloc) {
            __builtin_amdgcn_fence(__ATOMIC_RELEASE, "agent");
            asm volatile("s_waitcnt vmcnt(0)" ::: "memory");
            const unsigned og = xb_add(&bar[XB_TOP], 1u);
            const unsigned tg = og / nx;
            if (og + 1u == (tg + 1u) * nx) xb_add(&bar[XB_TOPGEN], 1u);
            else XB_SPIN(xb_ld(&bar[XB_TOPGEN]) == tg, bar);
            __builtin_amdgcn_fence(__ATOMIC_ACQUIRE, "agent");
            xb_add(&bar[XB_XGEN(b.x)], 1u);
            asm volatile("s_waitcnt vmcnt(0)" ::: "memory");
        } else {
            XB_SPIN(xb_ld(&bar[XB_XGEN(b.x)]) == gen, bar);
            __builtin_amdgcn_fence(__ATOMIC_ACQUIRE, "agent");
            asm volatile("s_waitcnt vmcnt(0)" ::: "memory");
        }
    }
    __syncthreads();
}
constexpr int DM = 2048, DFF = 5632, SEQ = 2048, DEPTH = 4, NSEQ = 24, NTOK = NSEQ * SEQ;
constexpr int TC = 16384, NCHUNK = NTOK / TC;
constexpr int NH = 12, HD = 128, ATTW = 1536, QKVW = 13824, INW = 14336, POOLW = 512;
constexpr int NGU = 2 * DFF;
constexpr float LOG2E = 1.4426950408889634f;
constexpr float QSCALE = 0.08838834764831845f * LOG2E;
constexpr int NSTEPS = 1 + NCHUNK * DEPTH * 8 + 1;

constexpr size_t MiB = 1u << 20;
constexpr size_t WS_CTL = 0, WS_CM = 1 * MiB, CTL_ZERO_BYTES = 2 * MiB;
constexpr int CM_IN = 0, CM_GU = 65536;
static_assert(DEPTH * 14336 <= CM_GU && (size_t)(CM_GU + 2 * DEPTH * 11264) * 4 <= 1 * MiB, "column-maxima map");
#ifndef DUP_GU8
#define DUP_GU8 1
#endif
#ifndef DUP_IN8
#define DUP_IN8 1
#endif
#ifndef ATT_SPLIT
#define ATT_SPLIT 1024
#endif
#ifndef I8_POOLIN
#define I8_POOLIN 0
#endif
#ifndef I8GU_MASK
#define I8GU_MASK 0xFFu
#endif
constexpr size_t WS_SR = 4 * MiB + 512 * 1024;
constexpr size_t WS_SA = 4 * MiB + 256 * 1024;
constexpr size_t WS_LUT = 4 * MiB, WS_WPT = 5 * MiB, WS_LSE = 6 * MiB;
constexpr size_t WS_W = 16 * MiB, W_LAYER = 196 * MiB;
constexpr size_t WO_GU0 = 0, WO_GU1 = 44 * MiB, WO_D0 = 88 * MiB, WO_D1 = 110 * MiB, WO_IN = 132 * MiB  , WO_INU = 160 * MiB  , WO_OUT = 188 * MiB;
constexpr float W8_SCALE = 64.0f;
constexpr size_t WS_XB = 800 * MiB, WS_H = 992 * MiB, WS_OG = WS_H, WS_Z = 1168 * MiB, WS_MIX = 1616 * MiB, WS_SS = 1680 * MiB, WS_XB8 = 1760 * MiB, WS_END = 1856 * MiB;
static_assert((size_t)NGU * DM * 2 == 44 * MiB && (size_t)DM * DFF * 2 == 22 * MiB && (size_t)INW * DM * 2 == 56 * MiB && (size_t)DM * DM * 2 == 8 * MiB, "weight map");
static_assert((size_t)NTOK * DM * 2 == 192 * MiB && (size_t)TC * DFF * 2 == 176 * MiB && (size_t)TC * INW * 2 == 448 * MiB && (size_t)TC * DM * 2 == 64 * MiB && (size_t)TC * 3 * ATTW * 2 <= 176 * MiB, "activation map");
static_assert(13 * (size_t)NTOK * 32 * 4 <= 80 * MiB && (size_t)TC * 36 * 4 <= 10 * MiB, "small buffers");
constexpr int CW_BAR = 4096;

constexpr int LDS_BYTES = 147456;
constexpr int ATT_K = 0, ATT_KP = 272, ATT_V = 256 * ATT_KP, ATT_VP = 288, ATT_LUT = ATT_V + 256 * ATT_VP;
constexpr int MISC_OFF = 146432;
static_assert(ATT_LUT + 768 <= MISC_OFF && MISC_OFF + 64 <= LDS_BYTES, "LDS map");

#define GAS __attribute__((address_space(1)))
typedef unsigned short bf16;
typedef unsigned u32x4 __attribute__((ext_vector_type(4)));
typedef unsigned u32x2 __attribute__((ext_vector_type(2)));
typedef float f32x4 __attribute__((ext_vector_type(4)));
typedef short bf16x8 __attribute__((ext_vector_type(8)));
typedef short s16x4 __attribute__((ext_vector_type(4)));
using pg8::cvt_pk_bf16;
#define LDS_WAIT() asm volatile("s_waitcnt lgkmcnt(0)" ::: "memory")
#define LDS_BARRIER() asm volatile("s_waitcnt lgkmcnt(0)\n\ts_barrier" ::: "memory")
__device__ __forceinline__ float bf_lo(unsigned w) { return __uint_as_float(w << 16); }
__device__ __forceinline__ float bf_hi(unsigned w) { return __uint_as_float(w & 0xffff0000u); }
__device__ __forceinline__ float wave_sum(float v) {
#pragma unroll
    for (int o = 1; o < 64; o <<= 1) v += __shfl_xor(v, o);
    return v;
}

#define W_OFF(n, kb, Kb) (PG8_B_BLOCKED ? pg8::bblk_off((n), (kb), (Kb)) : ((size_t)(n) * (size_t)(Kb) + (size_t)(kb)))
struct CvtItem { const float* src; const float* gk; unsigned char* dst; float* cm; int ldn, k0, c0, ldk, r0, fp8  ; float cs; };
__device__ __forceinline__ void cvt_colmax(const CvtItem& I, const float (&lv)[32], int lane) {
    float m = 0.f;
#pragma unroll
    for (int i = 0; i < 32; ++i) { const int kk = 2 * i + (lane >> 5); m = fmaxf(m, fabsf(lv[i] * (I.gk ? I.gk[I.k0 + kk] : 1.0f))); }
    m = fmaxf(m, __shfl_xor(m, 32));
    if (lane < 32) atomicMax((unsigned*)(I.cm + I.r0 + lane), __float_as_uint(m));
}
__device__ __forceinline__ void cvt_load(const CvtItem& I, float (&lv)[32], int lane) {
#pragma unroll
    for (int i = 0; i < 32; ++i) { const int kk = 2 * i + (lane >> 5); lv[i] = I.src[(size_t)(I.k0 + kk) * I.ldn + I.c0 + (lane & 31)]; }
}
__device__ __forceinline__ void cvt_store(const CvtItem& I, const float (&lv)[32], LAS float* scr, int lane) {
#pragma unroll
    for (int i = 0; i < 32; ++i) { const int kk = 2 * i + (lane >> 5); scr[kk * 33 + (lane & 31)] = lv[i]; }
    const int c = lane & 7;
    float gs[8];
#pragma unroll
    for (int j = 0; j < 8; ++j) gs[j] = I.gk ? I.gk[I.k0 + 8 * c + j] * I.cs : I.cs;
    LDS_WAIT(); asm volatile("" ::: "memory");
#pragma unroll
    for (int j = 0; j < 4; ++j) { const int n = (lane >> 3) + 8 * j; const LAS float* s = scr + (8 * c) * 33 + n;
        float v[8];
#pragma unroll
        for (int q = 0; q < 8; ++q) v[q] = s[q * 33] * gs[q];
        if (I.fp8) { const float cmv = I.cm[I.r0 + n], inv = cmv > 0.f ? 127.0f / cmv : 0.f; int q8[8];
#pragma unroll
            for (int q = 0; q < 8; ++q) { int t = (int)__builtin_rintf(v[q] * inv); t = t < -127 ? -127 : (t > 127 ? 127 : t); q8[q] = t & 0xff; }
            u32x2 o; o.x = (unsigned)q8[0] | ((unsigned)q8[1] << 8) | ((unsigned)q8[2] << 16) | ((unsigned)q8[3] << 24); o.y = (unsigned)q8[4] | ((unsigned)q8[5] << 8) | ((unsigned)q8[6] << 16) | ((unsigned)q8[7] << 24);
            *(u32x2*)(I.dst + W_OFF(I.r0 + n, I.k0 + 8 * c, I.ldk)) = o; }
        else { u32x4 o; o.x = cvt_pk_bf16(v[0], v[1]); o.y = cvt_pk_bf16(v[2], v[3]); o.z = cvt_pk_bf16(v[4], v[5]); o.w = cvt_pk_bf16(v[6], v[7]);
            *(u32x4*)(I.dst + W_OFF(I.r0 + n, (I.k0 + 8 * c) * 2, I.ldk * 2)) = o; } }
    LDS_WAIT(); asm volatile("" ::: "memory");
}
__device__ __forceinline__ void cvt_store8(const CvtItem& I, const float (&lv)[32], LAS float* scr, int lane, float cmv) {
#pragma unroll
    for (int i = 0; i < 32; ++i) { const int kk = 2 * i + (lane >> 5); scr[kk * 33 + (lane & 31)] = lv[i]; }
    const int c = lane & 7;
    float gs[8];
#pragma unroll
    for (int j = 0; j < 8; ++j) gs[j] = I.gk[I.k0 + 8 * c + j];
    LDS_WAIT(); asm volatile("" ::: "memory");
#pragma unroll
    for (int j = 0; j < 4; ++j) { const int n = (lane >> 3) + 8 * j; const LAS float* s = scr + (8 * c) * 33 + n;
        const float cmn = __shfl(cmv, n), inv = cmn > 0.f ? 127.0f / cmn : 0.f; int q8[8];
#pragma unroll
        for (int q = 0; q < 8; ++q) { int t = (int)__builtin_rintf(s[q * 33] * gs[q] * inv); t = t < -127 ? -127 : (t > 127 ? 127 : t); q8[q] = t & 0xff; }
        u32x2 o; o.x = (unsigned)q8[0] | ((unsigned)q8[1] << 8) | ((unsigned)q8[2] << 16) | ((unsigned)q8[3] << 24); o.y = (unsigned)q8[4] | ((unsigned)q8[5] << 8) | ((unsigned)q8[6] << 16) | ((unsigned)q8[7] << 24);
        *(u32x2*)(I.dst + W_OFF(I.r0 + n, I.k0 + 8 * c, I.ldk)) = o; }
    LDS_WAIT(); asm volatile("" ::: "memory");
}
__device__ __forceinline__ int t5_bucket(int rel) {
    const int n = rel < 0 ? -rel : rel; int b;
    if (n < 8) b = n; else if (n < 15) b = 8; else if (n < 27) b = 9; else if (n < 50) b = 10; else if (n < 91) b = 11; else if (n < 166) b = 12; else if (n < 305) b = 13; else if (n < 559) b = 14; else b = 15;
    return b + (rel > 0 ? 16 : 0);
}
struct Ptrs {
    const float *x_prompt, *x_sample, *norm_g, *ffn_gate, *ffn_up, *ffn_down, *w_in, *w_pool, *pool_scale, *w_out, *rel_bias, *final_g;
    float* out; unsigned char* ws;
};
__device__ __forceinline__ void prologue(const Ptrs& P, LAS unsigned char* lds, int tid, int lane, int wave, int G, int pass) {
    LAS float* scr = (LAS float*)(lds + wave * 8448);
    const int gw = blockIdx.x * 8 + wave, NGW = G * 8;
    constexpr int I_GU = 32 * 352, I_D = 88 * 64, I_IN = 32 * 448, I_OUT = 32 * 64, I_LAYER = 2 * I_GU + 2 * I_D + I_IN + I_OUT;
    auto decode = [&](int it) -> CvtItem {
        CvtItem I; const int l = it / I_LAYER; int r = it % I_LAYER;
        unsigned char* wl = P.ws + WS_W + (size_t)l * W_LAYER; I.fp8 = 0; I.cs = 1.0f; I.cm = nullptr; float* CM = (float*)(P.ws + WS_CM);
        if (r < 2 * I_GU) { const int j = r / I_GU; r %= I_GU; const int kb = r / 352, nb = r % 352, n0 = 32 * nb, pn = n0 >> 8, within = n0 & 255;
            I.src = ((within < 128) ? P.ffn_gate : P.ffn_up) + (size_t)(l * 2 + j) * DM * DFF; I.ldn = DFF; I.k0 = 64 * kb; I.c0 = 128 * pn + (within & 127);
            I.dst = wl + (j ? WO_GU1 : WO_GU0); I.ldk = DM; I.r0 = n0; I.gk = P.norm_g + (size_t)(l * 3 + 2 * j) * DM;
            if ((I8GU_MASK >> (l * 2 + j)) & 1u) { I.fp8 = 2; I.cm = CM + CM_GU + (l * 2 + j) * NGU; }
            return I; }
        r -= 2 * I_GU;
        if (r < 2 * I_D) { const int j = r / I_D; r %= I_D; const int kb = r / 64, nb = r % 64;
            I.src = P.ffn_down + (size_t)(l * 2 + j) * DFF * DM; I.ldn = DM; I.k0 = 64 * kb; I.c0 = 32 * nb; I.dst = wl + (j ? WO_D1 : WO_D0); I.ldk = DFF; I.r0 = 32 * nb; I.gk = nullptr; return I; }
        r -= 2 * I_D;
        if (r < I_IN) { const int kb = r / 448, nb = r % 448, n0 = 32 * nb;
            I.src = P.w_in + (size_t)l * DM * INW; I.ldn = INW; I.k0 = 64 * kb; I.c0 = n0; I.ldk = DM; I.gk = P.norm_g + (size_t)(l * 3 + 1) * DM;
#if I8_POOLIN
            I.dst = wl + WO_IN; I.r0 = n0; I.fp8 = 2; I.cm = CM + CM_IN + l * INW;
#else
            if (n0 < QKVW) { I.dst = wl + WO_IN; I.r0 = n0; I.fp8 = 2; I.cm = CM + CM_IN + l * INW; } else { I.dst = wl + WO_INU; I.r0 = n0 - QKVW; }
#endif
            return I; }
        r -= I_IN;
        { const int kb = r / 64, nb = r % 64;
            I.src = P.w_out + (size_t)l * DM * DM; I.ldn = DM; I.k0 = 64 * kb; I.c0 = 32 * nb; I.dst = wl + WO_OUT; I.ldk = DM; I.r0 = 32 * nb; I.gk = nullptr; return I; }
    };
    {
        LAS float* cmx = (LAS float*)(lds + 69632);
        constexpr int S_LAYER = 2 * 352 + 432;
        for (int sidx = blockIdx.x; sidx < DEPTH * S_LAYER; sidx += G) {
            const int l = sidx / S_LAYER, r = sidx % S_LAYER; int itb, kstride;
            if (r < 704) { const int j = r / 352; if (!((I8GU_MASK >> (l * 2 + j)) & 1u)) continue; itb = l * I_LAYER + j * I_GU + (r % 352); kstride = 352; }
            else { itb = l * I_LAYER + 2 * I_GU + 2 * I_D + (r - 704); kstride = 448; }
            float lv[4][32];
#pragma unroll
            for (int b = 0; b < 4; ++b) { const CvtItem I = decode(itb + (4 * wave + b) * kstride); cvt_load(I, lv[b], lane); }
            float m = 0.f;
#pragma unroll
            for (int b = 0; b < 4; ++b) { const CvtItem I = decode(itb + (4 * wave + b) * kstride);
#pragma unroll
                for (int i = 0; i < 32; ++i) { const int kk = 2 * i + (lane >> 5); m = fmaxf(m, fabsf(lv[b][i] * I.gk[I.k0 + kk])); } }
            m = fmaxf(m, __shfl_xor(m, 32));
            if (lane < 32) cmx[wave * 32 + lane] = m;
            __syncthreads();
            float cmv = 0.f;
#pragma unroll
            for (int w = 0; w < 8; ++w) cmv = fmaxf(cmv, cmx[w * 32 + (lane & 31)]);
            { const CvtItem I = decode(itb); if (wave == 0 && lane < 32) I.cm[I.r0 + lane] = cmv; }
#pragma unroll
            for (int b = 0; b < 4; ++b) { const CvtItem I = decode(itb + (4 * wave + b) * kstride); cvt_store8(I, lv[b], scr, lane, cmv); }
            __syncthreads();
        }
    }
    {
        constexpr int NIT = DEPTH * I_LAYER;
        auto next16 = [&](int it) -> int { while (it < NIT && decode(it).fp8 == 2) it += NGW; return it; };
        int itA = next16(gw), itB = (itA < NIT) ? next16(itA + NGW) : NIT; float lvA[32], lvB[32]; CvtItem curA, curB;
        if (itA < NIT) { curA = decode(itA); cvt_load(curA, lvA, lane); } else curA = decode(0);
        curB = curA; if (itB < NIT) { curB = decode(itB); cvt_load(curB, lvB, lane); }
        while (itA < NIT) {
            float lcA[32], lcB[32];
#pragma unroll
            for (int i = 0; i < 32; ++i) { lcA[i] = lvA[i]; lcB[i] = lvB[i]; }
            const int itA2 = (itB < NIT) ? next16(itB + NGW) : NIT, itB2 = (itA2 < NIT) ? next16(itA2 + NGW) : NIT; CvtItem nA = curA, nB = curB;
            if (itA2 < NIT) { nA = decode(itA2); cvt_load(nA, lvA, lane); }
            if (itB2 < NIT) { nB = decode(itB2); cvt_load(nB, lvB, lane); }
            asm volatile("" ::: "memory");
            cvt_store(curA, lcA, scr, lane);
            if (itB < NIT) cvt_store(curB, lcB, scr, lane);
            curA = nA; curB = nB; itA = itA2; itB = itB2;
        }
    }
    bf16* XB = (bf16*)(P.ws + WS_XB); float* SS = (float*)(P.ws + WS_SS);
    for (int rowa = gw; rowa < NTOK; rowa += 2 * NGW) {
        f32x4 v[2][8]; float s[2];
#pragma unroll
        for (int h = 0; h < 2; ++h) { const int row = rowa + h * NGW; s[h] = 0.f;
            if (row < NTOK) { const float* xr = (row < 16 * SEQ) ? P.x_prompt + (size_t)row * DM : P.x_sample + (size_t)(row - 16 * SEQ) * DM;
#pragma unroll
                for (int j = 0; j < 8; ++j) v[h][j] = *(const f32x4*)(xr + 4 * lane + 256 * j); }
            else {
#pragma unroll
                for (int j = 0; j < 8; ++j) v[h][j] = (f32x4){0.f, 0.f, 0.f, 0.f}; } }
#pragma unroll
        for (int h = 0; h < 2; ++h) { const int row = rowa + h * NGW; if (row >= NTOK) continue;
#pragma unroll
            for (int j = 0; j < 8; ++j) s[h] += (v[h][j][0] * v[h][j][0] + v[h][j][1] * v[h][j][1]) + (v[h][j][2] * v[h][j][2] + v[h][j][3] * v[h][j][3]);
            s[h] = wave_sum(s[h]);
#pragma unroll
            for (int j = 0; j < 8; ++j) { u32x2 o; o.x = cvt_pk_bf16(v[h][j][0], v[h][j][1]); o.y = cvt_pk_bf16(v[h][j][2], v[h][j][3]); *(u32x2*)(XB + (size_t)row * DM + 4 * lane + 256 * j) = o; }
            if (lane < 32) SS[(size_t)row * 32 + lane] = (lane == 0) ? s[h] : 0.f; }
    }
    float* LUT = (float*)(P.ws + WS_LUT);
    for (int i = blockIdx.x * 512 + tid; i < 36 * 192; i += G * 512) { const int gh = i / 192, idx = i % 192, d64 = idx - 16, g = gh / 12, dil = (g == 0) ? 1 : (g == 1 ? 4 : 16);
        LUT[i] = (d64 >= 0 && d64 <= 128) ? P.rel_bias[t5_bucket((d64 - 64) * dil) * 36 + gh] * LOG2E : -1e30f; }
    bf16* WPT = (bf16*)(P.ws + WS_WPT);
    for (int i = blockIdx.x * 512 + tid; i < DEPTH * 4 * 128 * 128; i += G * 512) { const int c = i & 127, e = (i >> 7) & 127, lg = i >> 14;
        WPT[i] = (bf16)(cvt_pk_bf16(P.w_pool[(size_t)lg * 16384 + c * 128 + e], 0.f) & 0xffffu); }
}

#ifndef QR
#define QR 4
#endif
template <bool WR> __device__ __forceinline__ void quant_rows(const bf16* __restrict__ xb, unsigned char* __restrict__ x8, float* __restrict__ sa, float* __restrict__ sr, const float* __restrict__ ssp, int lane, int wave, int G_) {
    const int gw = blockIdx.x * 8 + wave, NGW = G_ * 8;
    for (int rb = gw; rb < TC; rb += QR * NGW) {
        u32x4 v[QR][4]; float am[QR];
#pragma unroll
        for (int q = 0; q < QR; ++q) { const int row = rb + q * NGW;
#pragma unroll
            for (int j = 0; j < 4; ++j) v[q][j] = (row < TC) ? *(const u32x4*)(xb + (size_t)row * DM + 8 * lane + 512 * j) : (u32x4){0u, 0u, 0u, 0u}; }
#pragma unroll
        for (int q = 0; q < QR; ++q) { float a = 0.f;
#pragma unroll
            for (int j = 0; j < 4; ++j)
#pragma unroll
                for (int k = 0; k < 4; ++k) a = fmaxf(a, fmaxf(fabsf(bf_lo(v[q][j][k])), fabsf(bf_hi(v[q][j][k]))));
#pragma unroll
            for (int o = 1; o < 64; o <<= 1) a = fmaxf(a, __shfl_xor(a, o));
            am[q] = a; }
#pragma unroll
        for (int q = 0; q < QR; ++q) { const int row = rb + q * NGW; if (row >= TC) continue;
            const float inv = am[q] > 0.f ? 127.0f / am[q] : 0.f;
            { float sp = (lane < 32) ? ssp[(size_t)row * 32 + lane] : 0.f;
#pragma unroll
              for (int o = 1; o < 32; o <<= 1) sp += __shfl_xor(sp, o);
              const float rstd = __builtin_amdgcn_rsqf(sp * pg8::INV_D + pg8::RMS_EPS);
              if (lane == 0) { sa[row] = am[q] * (1.0f / 127.0f) * rstd; if (WR) sr[row] = rstd; } }
#pragma unroll
            for (int j = 0; j < 4; ++j) { u32x2 o; int q8[8];
#pragma unroll
                for (int k = 0; k < 4; ++k) { int t0 = (int)__builtin_rintf(bf_lo(v[q][j][k]) * inv), t1 = (int)__builtin_rintf(bf_hi(v[q][j][k]) * inv);
                    t0 = t0 < -127 ? -127 : (t0 > 127 ? 127 : t0); t1 = t1 < -127 ? -127 : (t1 > 127 ? 127 : t1); q8[2 * k] = t0 & 0xff; q8[2 * k + 1] = t1 & 0xff; }
                o.x = (unsigned)q8[0] | ((unsigned)q8[1] << 8) | ((unsigned)q8[2] << 16) | ((unsigned)q8[3] << 24); o.y = (unsigned)q8[4] | ((unsigned)q8[5] << 8) | ((unsigned)q8[6] << 16) | ((unsigned)q8[7] << 24);
                *(u32x2*)(x8 + (size_t)row * DM + 8 * lane + 512 * j) = o; } }
    }
}

struct AttnUnit { const bf16* zb; size_t tstride; int L, i0, dil, gh, tokbase, nsteps; };
template <int MODE> __device__ __forceinline__ AttnUnit attn_decode(const bf16* z, int u) {
    AttnUnit a; int bh, g, c, seg;
    if (MODE) { bh = u >> 3; g = 0; c = 0; seg = u & 7; a.dil = 1; a.nsteps = 2; }
    else if (u < 768) { bh = u >> 3; g = 1; c = (u & 7) >> 1; seg = u & 1; a.dil = 4; a.nsteps = 2; }
    else { const int v = u - 768; bh = v >> 4; g = 2; c = v & 15; seg = 0; a.dil = 16; a.nsteps = 1; }
    const int b = bh / NH, h = bh % NH;
    a.L = SEQ / a.dil; a.i0 = seg * 256; a.tstride = (size_t)a.dil * INW; a.gh = g * NH + h; a.tokbase = b * SEQ + c;
    a.zb = z + (size_t)a.tokbase * INW + g * 4608 + h * HD;
    return a;
}
struct AttnRegs { u32x4 kv[8], vv[8]; bf16x8 qf[4]; float lutv; };
__device__ __forceinline__ void attn_issue(const AttnUnit& a, int i0s, bool first, AttnRegs& R, const float* __restrict__ lutg, int tid, int lane, int wave) {
    const int kstart = i0s - 64, sb = i0s & 255;
#pragma unroll
    for (int it = 0; it < 8; ++it) { const int id = tid + 512 * it, slot = id >> 4, cc = id & 15, p = (slot - sb) & 255, ki = kstart + p;
        R.kv[it] = (u32x4){0u, 0u, 0u, 0u}; R.vv[it] = (u32x4){0u, 0u, 0u, 0u};
        if ((first || p >= 128) && ki >= 0 && ki < a.L) { const bf16* q = a.zb + (size_t)ki * a.tstride + cc * 8; R.kv[it] = *(const u32x4*)(q + 1536); R.vv[it] = *(const u32x4*)(q + 3072); } }
    const bf16* qp = a.zb + (size_t)(i0s + 16 * wave + (lane & 15)) * a.tstride + 8 * (lane >> 4);
#pragma unroll
    for (int ks = 0; ks < 4; ++ks) R.qf[ks] = *(const bf16x8*)(qp + 32 * ks);
    R.lutv = (tid < 192) ? lutg[a.gh * 192 + tid] : 0.f;
}
template <int MODE> __device__ __forceinline__ void attn_phase(const bf16* __restrict__ z, bf16* og, float* lse, bf16* __restrict__ mix, const float* __restrict__ lutg, LAS unsigned char* lds, int tid, int lane, int wave, int u0, int G_, int nunits) {
    if (u0 >= nunits) return;
    const int qi = lane & 15, G = lane >> 4;
    LAS unsigned char* Kl = lds + ATT_K; LAS unsigned char* Vl = lds + ATT_V; LAS float* lut = (LAS float*)(lds + ATT_LUT);
    int u = u0, st = 0; AttnUnit cur = attn_decode<MODE>(z, u); AttnRegs R; attn_issue(cur, cur.i0, true, R, lutg, tid, lane, wave);
#if defined(DUP_ATTX)
    int reps_left = (MODE == DUP_ATTX_MODE) ? DUP_ATTX - 1 : 0;
#endif
    for (;;) {
        const int i0s = cur.i0 + 128 * st, sb = i0s & 255; const bool first = (st == 0);
#pragma unroll
        for (int it = 0; it < 8; ++it) { const int id = tid + 512 * it, slot = id >> 4, cc = id & 15, p = (slot - sb) & 255;
            if (first || p >= 128) { *(LAS u32x4*)(Kl + slot * ATT_KP + cc * 16) = R.kv[it]; *(LAS u32x4*)(Vl + slot * ATT_VP + cc * 16) = R.vv[it]; } }
        if (tid < 192) lut[tid] = R.lutv;
        bf16x8 qf[4];
#pragma unroll
        for (int ks = 0; ks < 4; ++ks) qf[ks] = R.qf[ks];
        LDS_BARRIER();
        int un = u, stn = st + 1; AttnUnit nxt = cur; bool has_next = true;
        if (stn >= cur.nsteps) { un = u + G_; stn = 0; has_next = un < nunits;
#if defined(DUP_ATTX)
            if (!has_next && reps_left > 0) { --reps_left; un = u0; has_next = true; }
#endif
            if (has_next) nxt = attn_decode<MODE>(z, un); }
        if (has_next) attn_issue(nxt, nxt.i0 + 128 * stn, stn == 0, R, lutg, tid, lane, wave);
        asm volatile("" ::: "memory");
        const int L = cur.L, kw0 = 16 * wave, kbase = i0s - 64 + kw0;
        const size_t tokrow = (size_t)cur.tokbase + (size_t)(i0s + 16 * wave + qi) * cur.dil;
        f32x4 s[9];
        {
            const int rb = sb + kw0 + qi;
            const LAS unsigned char* kcol = Kl + 16 * G;
            bf16x8 ka[2][4];
#pragma unroll
            for (int ks = 0; ks < 4; ++ks) ka[0][ks] = *(const LAS bf16x8*)(kcol + (rb & 255) * ATT_KP + 64 * ks);
#pragma unroll
            for (int kt = 0; kt < 9; ++kt) {
                if (kt + 1 < 9) {
#pragma unroll
                    for (int ks = 0; ks < 4; ++ks) ka[(kt + 1) & 1][ks] = *(const LAS bf16x8*)(kcol + ((rb + 16 * (kt + 1)) & 255) * ATT_KP + 64 * ks); }
                f32x4 a4 = (f32x4){0.f, 0.f, 0.f, 0.f};
#pragma unroll
                for (int ks = 0; ks < 4; ++ks) a4 = __builtin_amdgcn_mfma_f32_16x16x32_bf16(ka[kt & 1][ks], qf[ks], a4, 0, 0, 0);
                s[kt] = a4; }
        }
        float m = -3.0e38f;
        {
            const LAS float* lb = lut + (4 * G - qi + 16);
            float bv[9][4];
#pragma unroll
            for (int kt = 0; kt < 9; ++kt)
#pragma unroll
                for (int rr = 0; rr < 4; ++rr) bv[kt][rr] = lb[16 * kt + rr];
#pragma unroll
            for (int kt = 0; kt < 9; ++kt) { const bool tv = (kbase + 16 * kt >= 0) && (kbase + 16 * kt < L);
#pragma unroll
                for (int rr = 0; rr < 4; ++rr) { const float v = tv ? s[kt][rr] + bv[kt][rr] : -1e30f; s[kt][rr] = v; m = fmaxf(m, v); } }
        }
        m = fmaxf(m, __shfl_xor(m, 16)); m = fmaxf(m, __shfl_xor(m, 32));
        float lsum = 0.f;
#pragma unroll
        for (int kt = 0; kt < 9; ++kt)
#pragma unroll
            for (int rr = 0; rr < 4; ++rr) { const float p = __builtin_amdgcn_exp2f(s[kt][rr] - m); s[kt][rr] = p; lsum += p; }
        lsum += __shfl_xor(lsum, 16); lsum += __shfl_xor(lsum, 32);
        u32x2 o1[8], o2[8]; float l1 = 0.f, l2 = 0.f;
        if (MODE == 1) {
            const bf16* gp = og + tokrow * (3 * ATTW) + cur.gh * HD + 32 * G;
#pragma unroll
            for (int dq = 0; dq < 4; ++dq) { const u32x4 a = *(const u32x4*)(gp + ATTW + 8 * dq), b = *(const u32x4*)(gp + 2 * ATTW + 8 * dq);
                o1[2 * dq] = (u32x2){a.x, a.y}; o1[2 * dq + 1] = (u32x2){a.z, a.w}; o2[2 * dq] = (u32x2){b.x, b.y}; o2[2 * dq + 1] = (u32x2){b.z, b.w}; }
            l1 = lse[tokrow * 36 + 12 + cur.gh]; l2 = lse[tokrow * 36 + 24 + cur.gh];
            asm volatile("" ::: "memory");
        }
        f32x4 o[8];
#pragma unroll
        for (int db = 0; db < 8; ++db) o[db] = (f32x4){0.f, 0.f, 0.f, 0.f};
#pragma unroll
        for (int kp = 0; kp < 5; ++kp) {
            u32x4 pw; pw.x = cvt_pk_bf16(s[2 * kp][0], s[2 * kp][1]); pw.y = cvt_pk_bf16(s[2 * kp][2], s[2 * kp][3]);
            if (kp < 4) { pw.z = cvt_pk_bf16(s[2 * kp + 1][0], s[2 * kp + 1][1]); pw.w = cvt_pk_bf16(s[2 * kp + 1][2], s[2 * kp + 1][3]); } else { pw.z = 0u; pw.w = 0u; }
            const bf16x8 pb = __builtin_bit_cast(bf16x8, pw);
            const int rowA = (sb + kw0 + 32 * kp + 4 * G + (qi >> 2)) & 255, rowB = (rowA + 16) & 255;
            const LAS unsigned char* pa = Vl + rowA * ATT_VP + (qi & 3) * 8; const LAS unsigned char* pbv = Vl + rowB * ATT_VP + (qi & 3) * 8;
#pragma unroll
            for (int db = 0; db < 8; ++db) {
                const s16x4 t0 = __builtin_bit_cast(s16x4, __builtin_amdgcn_ds_read_tr16_b64_v4i16((LAS s16x4*)(pa + db * 32)));
                const s16x4 t1 = __builtin_bit_cast(s16x4, __builtin_amdgcn_ds_read_tr16_b64_v4i16((LAS s16x4*)(pbv + db * 32)));
                const bf16x8 a = (bf16x8){t0[0], t0[1], t0[2], t0[3], t1[0], t1[1], t1[2], t1[3]};
                o[db] = __builtin_amdgcn_mfma_f32_16x16x32_bf16(a, pb, o[db], 0, 0, 0); }
        }
        const float inv = __builtin_amdgcn_rcpf(lsum);
        if (MODE == 0) {
            bf16* op = og + tokrow * (3 * ATTW) + cur.gh * HD + 32 * G;
#pragma unroll
            for (int dq = 0; dq < 4; ++dq) { u32x4 w; w.x = cvt_pk_bf16(o[2 * dq][0] * inv, o[2 * dq][1] * inv); w.y = cvt_pk_bf16(o[2 * dq][2] * inv, o[2 * dq][3] * inv);
                w.z = cvt_pk_bf16(o[2 * dq + 1][0] * inv, o[2 * dq + 1][1] * inv); w.w = cvt_pk_bf16(o[2 * dq + 1][2] * inv, o[2 * dq + 1][3] * inv); *(u32x4*)(op + 8 * dq) = w; }
            if (G == 0) lse[tokrow * 36 + cur.gh] = m + __builtin_amdgcn_logf(lsum);
        } else {
            const float l0 = m + __builtin_amdgcn_logf(lsum), mx = fmaxf(l0, fmaxf(l1, l2));
            float w0 = __builtin_amdgcn_exp2f(l0 - mx), w1 = __builtin_amdgcn_exp2f(l1 - mx), w2 = __builtin_amdgcn_exp2f(l2 - mx);
            const float wi = __builtin_amdgcn_rcpf(w0 + w1 + w2); w0 *= wi * inv; w1 *= wi; w2 *= wi;
            bf16* mp = mix + tokrow * DM + cur.gh * HD + 4 * G;
#pragma unroll
            for (int db = 0; db < 8; ++db) { u32x2 w;
                w.x = cvt_pk_bf16(w0 * o[db][0] + w1 * bf_lo(o1[db].x) + w2 * bf_lo(o2[db].x), w0 * o[db][1] + w1 * bf_hi(o1[db].x) + w2 * bf_hi(o2[db].x));
                w.y = cvt_pk_bf16(w0 * o[db][2] + w1 * bf_lo(o1[db].y) + w2 * bf_lo(o2[db].y), w0 * o[db][3] + w1 * bf_hi(o1[db].y) + w2 * bf_hi(o2[db].y));
                *(u32x2*)(mp + 16 * db) = w; }
        }
        LDS_BARRIER();
        if (!has_next) break;
        cur = nxt; u = un; st = stn;
    }
}

template <int HW> __device__ __forceinline__ void pool_task(const bf16* __restrict__ z, bf16* __restrict__ mix, const bf16* __restrict__ wpt, const float* __restrict__ pscale, int pg, int tile, int lane) {
    const int qi = lane & 15, Gq = lane >> 4, tt = tile * 16 + qi, spos = tt & (SEQ - 1);
    const int lo = (spos - HW) < 0 ? 0 : spos - HW, hi = (spos + HW + 1) > SEQ ? SEQ : spos + HW + 1; const float rc = 1.0f / (float)(hi - lo);
    const bf16* ub = z + (size_t)(tt - spos) * INW + QKVW + pg * 128 + 8 * Gq;
    bf16x8 df[4];
#pragma unroll
    for (int ks = 0; ks < 4; ++ks) { float acc[8];
#pragma unroll
        for (int k = 0; k < 8; ++k) acc[k] = 0.f;
        u32x4 sv;
#pragma unroll
        for (int w0 = 0; w0 < 2 * HW + 1; w0 += 9) {
            constexpr int NB = 9; u32x4 wv[NB];
#pragma unroll
            for (int w = 0; w < NB; ++w) if (w0 + w < 2 * HW + 1) { int sp = spos - HW + w0 + w; sp = sp < 0 ? 0 : (sp > SEQ - 1 ? SEQ - 1 : sp); wv[w] = *(const u32x4*)(ub + (size_t)sp * INW + 32 * ks); }
#pragma unroll
            for (int w = 0; w < NB; ++w) if (w0 + w < 2 * HW + 1) { const int sp = spos - HW + w0 + w; const float msk = (sp >= 0 && sp < SEQ) ? 1.0f : 0.0f;
                if (w0 + w == HW) sv = wv[w];
#pragma unroll
                for (int k = 0; k < 4; ++k) { acc[2 * k] += msk * bf_lo(wv[w][k]); acc[2 * k + 1] += msk * bf_hi(wv[w][k]); } }
            if (2 * HW + 1 > 9) asm volatile("" ::: "memory");
        }
        u32x4 dw;
#pragma unroll
        for (int k = 0; k < 4; ++k) dw[k] = cvt_pk_bf16(acc[2 * k] * rc - bf_lo(sv[k]), acc[2 * k + 1] * rc - bf_hi(sv[k]));
        df[ks] = __builtin_bit_cast(bf16x8, dw);
        asm volatile("" ::: "memory"); }
    const bf16* wb = wpt + (size_t)pg * 16384 + (size_t)qi * 128 + 8 * Gq;
    bf16* mp = mix + (size_t)tt * DM + ATTW + pg * 128 + 4 * Gq;
#pragma unroll
    for (int eb = 0; eb < 8; ++eb) { f32x4 a4 = (f32x4){0.f, 0.f, 0.f, 0.f};
#pragma unroll
        for (int ks = 0; ks < 4; ++ks) { const bf16x8 wf = *(const bf16x8*)(wb + (size_t)eb * 16 * 128 + 32 * ks); a4 = __builtin_amdgcn_mfma_f32_16x16x32_bf16(wf, df[ks], a4, 0, 0, 0); }
        const f32x4 ps = *(const f32x4*)(pscale + pg * 128 + 16 * eb + 4 * Gq);
        u32x2 w; w.x = cvt_pk_bf16(a4[0] * ps[0], a4[1] * ps[1]); w.y = cvt_pk_bf16(a4[2] * ps[2], a4[3] * ps[3]); *(u32x2*)(mp + 16 * eb) = w; }
}
__device__ __forceinline__ void pool_phase(const bf16* __restrict__ z, bf16* __restrict__ mix, const bf16* __restrict__ wpt  , const float* __restrict__ pscale  , int lane, int wave, int G_) {
    const int gw = blockIdx.x * 8 + wave, NGW = G_ * 8;
    for (int tile = (gw + 0 * (NGW / 4)) % NGW; tile < TC / 16; tile += NGW) pool_task<1>(z, mix, wpt, pscale, 0, tile, lane);
    for (int tile = (gw + 1 * (NGW / 4)) % NGW; tile < TC / 16; tile += NGW) pool_task<2>(z, mix, wpt, pscale, 1, tile, lane);
    for (int tile = (gw + 2 * (NGW / 4)) % NGW; tile < TC / 16; tile += NGW) pool_task<4>(z, mix, wpt, pscale, 2, tile, lane);
    for (int tile = (gw + 3 * (NGW / 4)) % NGW; tile < TC / 16; tile += NGW) pool_task<8>(z, mix, wpt, pscale, 3, tile, lane);
}

__device__ __forceinline__ void final_norm(float* out, const bf16* xbf, const float* ss, const float* fg, int lane, int wave, int G_) {
    const int gw = blockIdx.x * 8 + wave, NGW = G_ * 8;
    f32x4 gv[8];
#pragma unroll
    for (int j = 0; j < 4; ++j) { gv[2 * j] = *(const f32x4*)(fg + 8 * lane + 512 * j); gv[2 * j + 1] = *(const f32x4*)(fg + 8 * lane + 512 * j + 4); }
    for (int row = gw; row < NTOK; row += NGW) { const float rs = __builtin_amdgcn_rsqf(wave_sum(lane < 32 ? ss[(size_t)row * 32 + lane] : 0.f) * pg8::INV_D + pg8::RMS_EPS);
        const bf16* xr = xbf + (size_t)row * DM + 8 * lane; float* orow = out + (size_t)row * DM + 8 * lane;
#pragma unroll
        for (int j = 0; j < 4; ++j) { const u32x4 v = *(const u32x4*)(xr + 512 * j);
            f32x4 a = (f32x4){bf_lo(v[0]), bf_hi(v[0]), bf_lo(v[1]), bf_hi(v[1])}, b = (f32x4){bf_lo(v[2]), bf_hi(v[2]), bf_lo(v[3]), bf_hi(v[3])};
            *(f32x4*)(orow + 512 * j) = a * rs * gv[2 * j]; *(f32x4*)(orow + 512 * j + 4) = b * rs * gv[2 * j + 1]; } }
}

#define SITE_IDS() int tid = (wave0_ << 6) | pg8::lane_id_fresh(); asm volatile("" : "+v"(tid)); const int lane = tid & 63, wave = __builtin_amdgcn_readfirstlane(tid >> 6); (void)lane; (void)wave
struct SkipOrder : pg8::StaticOrder { __device__ bool next(int i, pg8::Unit& u) const { if (!pg8::StaticOrder::next(i, u)) return false; if (u.pn >= 16) u.pn += 2; return true; } };
struct PairOrder : pg8::StaticOrder { __device__ bool next(int i, pg8::Unit& u) const { if (!pg8::StaticOrder::next(i, u)) return false; u.pn += 16; return true; } };
struct HotOrder : pg8::StaticOrder { bool hot;
    __device__ bool next(int i, pg8::Unit& u) const { if (!pg8::StaticOrder::next(i, u)) return false; if (hot) { u.pm = c & 7; u.pn = (c >> 3) & 1; } return true; }
};
struct RangeOrder : pg8::StaticOrder { int lo, hi;
    __device__ bool next(int i, pg8::Unit& u) const { if (lo + i >= hi) return false; return pg8::StaticOrder::next(lo + i, u); }
};
#ifndef DUP_ATT
#define DUP_ATT 1
#endif
#ifndef DUP_ATT1
#define DUP_ATT1 1
#endif
#ifndef DUP_BAR
#define DUP_BAR 1
#endif
#ifndef DUP_MP
#define DUP_MP 1
#endif
#ifndef DUP_GU
#define DUP_GU 1
#endif
#ifndef DUP_IN
#define DUP_IN 1
#endif
#ifndef DUP_DN
#define DUP_DN 1
#endif
#ifndef DUP_OUT
#define DUP_OUT 1
#endif
#ifndef GP_ALIGN
#define GP_ALIGN true
#endif
#ifndef GP_ALIGN8
#define GP_ALIGN8 true
#endif
#ifndef GP_SP28
#define GP_SP28 true
#endif
#ifndef GP_SP2
#define GP_SP2 true
#endif
#ifndef WGM_GU
#define WGM_GU 4
#endif
#ifndef WGM_GU8
#define WGM_GU8 4
#endif
#ifndef WGM_IN8
#define WGM_IN8 6
#endif
#ifndef WGM_N2K
#define WGM_N2K 4
#endif
#ifndef ROT_IN8
#define ROT_IN8 1
#endif
#ifndef PMX_DN
#define PMX_DN 4
#endif
#ifndef PMX_OUT
#define PMX_OUT 0
#endif
#ifndef DUP_PRO
#define DUP_PRO 1
#endif
struct Args { Ptrs p; int lo, hi; };
__global__ void __launch_bounds__(512, 2) fwd(Args args) {
    extern __shared__ __attribute__((aligned(16))) unsigned char lds_raw[];
    LAS unsigned char* lds = (LAS unsigned char*)lds_raw;
    const int G = gridDim.x;
    const Ptrs& P = args.p;
    unsigned char* ws = P.ws;
    volatile LAS unsigned* MISC = (volatile LAS unsigned*)(lds + MISC_OFF);
    if (threadIdx.x < 16) MISC[threadIdx.x] = 0u;
    __syncthreads();
    XcdBarrier bar = xcd_barrier_post((unsigned*)(ws + WS_CTL) + CW_BAR, MISC + 8);
    const int wave0_ = (int)bar.wv;
    const int lo = args.lo, hi = args.hi;
    int step = 0;
#define RUN_STEP (step >= lo && step < hi)
#define END_STEP do { if (step >= lo && step + 1 < hi) { for (int rep_ = 0; rep_ < DUP_BAR; ++rep_) xcd_barrier(bar); } ++step; } while (0)
    float* SS = (float*)(ws + WS_SS);
    bf16* XB = (bf16*)(ws + WS_XB); bf16* HB = (bf16*)(ws + WS_H); bf16* OG = (bf16*)(ws + WS_OG); bf16* ZB = (bf16*)(ws + WS_Z); bf16* MIX = (bf16*)(ws + WS_MIX);
    float* LSE = (float*)(ws + WS_LSE);

    if (RUN_STEP) { SITE_IDS(); for (int rep = 0; rep < DUP_PRO; ++rep) prologue(P, lds, tid, lane, wave, G, 0); }
    END_STEP;

    for (int c = 0; c < NCHUNK; ++c) {
        const size_t r0 = (size_t)c * TC;
        bf16* xb = XB + r0 * DM;
        for (int i = 0; i < 2 * DEPTH; ++i) {
            const int l = i >> 1, j = i & 1;
            const unsigned char* wl = ws + WS_W + (size_t)l * W_LAYER;
            const bool gu8 = ((I8GU_MASK >> i) & 1u) != 0u;
            if (I8GU_MASK != 0u && gu8) {
                if (RUN_STEP) { SITE_IDS(); quant_rows<false>(xb, ws + WS_XB8 + r0 * DM, (float*)(ws + WS_SA) + r0, nullptr, SS + ((size_t)(3 * l + 2 * j) * NTOK + r0) * 32, lane, wave, G); }
                END_STEP;
                if (RUN_STEP) { pg8::Gemm g{(const bf16*)(ws + WS_XB8 + r0 * DM), (const bf16*)(wl + (j ? WO_GU1 : WO_GU0)), TC, NGU, DM}; pg8::StaticOrder S; S.init(TC, NGU, G, (int)blockIdx.x, WGM_GU8);
                    pg8::EpiSwiGLUI8 E{HB, DFF, (const float*)ws, (unsigned)(WS_SA + r0 * 4), (unsigned)(WS_CM + (size_t)(CM_GU + i * NGU) * 4)};
                    for (int rep = 0; rep < DUP_GU8; ++rep) pg8::gemm_phase<pg8::EpiSwiGLUI8, pg8::StaticOrder, GP_ALIGN8, GP_SP28, 3>(lds, g, S, E, wave0_); }
                END_STEP;
            } else {
            if (RUN_STEP) { pg8::Gemm g{xb, (const bf16*)(wl + (j ? WO_GU1 : WO_GU0)), TC, NGU, DM}; pg8::StaticOrder S; S.init(TC, NGU, G, (int)blockIdx.x, WGM_GU);
                pg8::EpiSwiGLU E{HB, DFF, SS + ((size_t)(3 * l + 2 * j) * NTOK + r0) * 32};
#if defined(HOT_GU)
                HotOrder S2; S2.init(TC, NGU, G, (int)blockIdx.x);
                for (int rep = 0; rep < 2; ++rep) { S2.hot = (rep == 0); pg8::EpiSwiGLU E2{rep == 0 ? (bf16*)(ws + WS_END) : HB, DFF, SS + ((size_t)(3 * l + 2 * j) * NTOK + r0) * 32};
                  pg8::gemm_phase<pg8::EpiSwiGLU, HotOrder, GP_ALIGN, GP_SP2>(lds, g, S2, E2, wave0_); }
#else
#if defined(PROBE_SPLIT)
                { RangeOrder S3; S3.init(TC, NGU, G, (int)blockIdx.x, WGM_GU); S3.lo = 0; S3.hi = 5; pg8::gemm_phase<pg8::EpiSwiGLU, RangeOrder, GP_ALIGN, GP_SP2>(lds, g, S3, E, wave0_);
                  xcd_barrier(bar);
                  S3.lo = 5; S3.hi = 11; pg8::gemm_phase<pg8::EpiSwiGLU, RangeOrder, GP_ALIGN, GP_SP2>(lds, g, S3, E, wave0_); }
#else
                for (int rep = 0; rep < DUP_GU; ++rep) pg8::gemm_phase<pg8::EpiSwiGLU, pg8::StaticOrder, GP_ALIGN, GP_SP2>(lds, g, S, E, wave0_);
#endif
#endif
                }
            END_STEP;
            }
            if (RUN_STEP) { pg8::Gemm g{HB, (const bf16*)(wl + (j ? WO_D1 : WO_D0)), TC, DM, DFF}; pg8::StaticOrder S; S.init(TC, DM, G, (int)blockIdx.x, WGM_N2K, 1, PMX_DN);
                pg8::EpiResidual E{xb, SS + ((size_t)(3 * l + 2 * j + 1) * NTOK + r0) * 32, 0.5f, nullptr, xb};
#if defined(PROBE_DN)
                for (int rep = 0; rep < 2; ++rep) { pg8::EpiResidual E2 = E; if (rep == 0) { E2.xw = (bf16*)(ws + WS_END); E2.ssn = SS + (size_t)13 * NTOK * 32; E2.x8 = nullptr; } pg8::gemm_phase<pg8::EpiResidual, pg8::StaticOrder, GP_ALIGN, GP_SP2>(lds, g, S, E2, wave0_); }
#else
                pg8::gemm_phase<pg8::EpiResidual, pg8::StaticOrder, false, GP_SP2>(lds, g, S, E, wave0_);
#endif
                }
            END_STEP;
            if (j == 0) {
                if (RUN_STEP) { SITE_IDS(); quant_rows<true>(xb, ws + WS_XB8 + r0 * DM, (float*)(ws + WS_SA) + r0, (float*)(ws + WS_SR) + r0, SS + ((size_t)(3 * l + 1) * NTOK + r0) * 32, lane, wave, G); }
                END_STEP;
                if (RUN_STEP) {
                    { constexpr int NIN8 = I8_POOLIN ? INW : QKVW;
                      pg8::Gemm g{(const bf16*)(ws + WS_XB8 + r0 * DM), (const bf16*)(wl + WO_IN), TC, NIN8, DM}; SkipOrder S; S.init(TC, NIN8 - 512, G, (int)blockIdx.x, WGM_IN8, ROT_IN8);
                      pg8::EpiScaleI8 E{ZB, INW, (const float*)ws, (unsigned)(WS_SA + r0 * 4), (unsigned)(WS_CM + (size_t)(CM_IN + l * INW) * 4), QSCALE, 1.0f};
                      for (int rep = 0; rep < DUP_IN8; ++rep) pg8::gemm_phase<pg8::EpiScaleI8, SkipOrder, GP_ALIGN8, GP_SP28, 3>(lds, g, S, E, wave0_); }
                    }
                END_STEP;
                if (RUN_STEP) {
                    { pg8::Gemm g{(const bf16*)(ws + WS_XB8 + r0 * DM), (const bf16*)(wl + WO_IN), TC, QKVW, DM}; PairOrder S; S.init(TC, 512, G, (int)blockIdx.x, 4, 0);
                      pg8::EpiScaleI8 E{ZB, INW, (const float*)ws, (unsigned)(WS_SA + r0 * 4), (unsigned)(WS_CM + (size_t)(CM_IN + l * INW) * 4), QSCALE, 1.0f};
                      pg8::gemm_phase<pg8::EpiScaleI8, PairOrder, GP_ALIGN8, GP_SP28, 3>(lds, g, S, E, wave0_); }
                    if (!I8_POOLIN) { pg8::Gemm g{xb, (const bf16*)(wl + WO_INU), TC, POOLW, DM}; pg8::StaticOrder S; S.init(TC, POOLW, G, ((int)blockIdx.x + G / 2) % G);
                      pg8::EpiScaleBf16 E{ZB + QKVW, INW, (const float*)(ws + WS_SR) + r0, 1.0f, 1.0f, 0};
                      pg8::gemm_phase<pg8::EpiScaleBf16, pg8::StaticOrder, GP_ALIGN, GP_SP2, 2>(lds, g, S, E, wave0_); }
                    SITE_IDS(); const int n0 = G - G / 2, n1 = G / 2, bx = (int)blockIdx.x; const bool up = bx >= n0;
                    const int ci = (G % 16 == 0) ? (bx % 8) * (G / 16) + (bx / 8) % (G / 16) : (up ? bx - n0 : bx);
                    for (int rep = 0; rep < DUP_ATT; ++rep) attn_phase<0>(ZB, OG, LSE, MIX, (const float*)(ws + WS_LUT), lds, tid, lane, wave, up ? ATT_SPLIT + ci : ci, up ? n1 : n0, up ? 2304 : ATT_SPLIT); }
                END_STEP;
                if (RUN_STEP) { SITE_IDS(); const int vcu = (G % 8 == 0) ? ((int)blockIdx.x % 8) * (G / 8) + (int)blockIdx.x / 8 : (int)blockIdx.x;
                    for (int rep = 0; rep < DUP_ATT1; ++rep) attn_phase<1>(ZB, OG, LSE, MIX, (const float*)(ws + WS_LUT), lds, tid, lane, wave, vcu, G, 768); }
                if (RUN_STEP) { SITE_IDS();
                    for (int rep = 0; rep < DUP_MP; ++rep) pool_phase(ZB, MIX, (const bf16*)(ws + WS_WPT) + (size_t)l * 4 * 16384, P.pool_scale + l * POOLW, lane, wave, G); }
                END_STEP;
                if (RUN_STEP) { pg8::Gemm g{MIX, (const bf16*)(wl + WO_OUT), TC, DM, DM}; pg8::StaticOrder S; S.init(TC, DM, G, (int)blockIdx.x, WGM_N2K, 1, PMX_OUT);
                    pg8::EpiResidual E{xb, SS + ((size_t)(3 * l + 2) * NTOK + r0) * 32, 1.0f, nullptr, xb};
#if defined(PROBE_OUT)
                    for (int rep = 0; rep < 2; ++rep) { pg8::EpiResidual E2 = E; if (rep == 0) { E2.xw = (bf16*)(ws + WS_END); E2.ssn = SS + (size_t)13 * NTOK * 32; } pg8::gemm_phase<pg8::EpiResidual, pg8::StaticOrder, GP_ALIGN, GP_SP2>(lds, g, S, E2, wave0_); }
#else
                    pg8::gemm_phase<pg8::EpiResidual, pg8::StaticOrder, false, GP_SP2>(lds, g, S, E, wave0_);
#endif
                    }
                END_STEP;
            }
        }
    }
    if (RUN_STEP) { SITE_IDS(); final_norm(P.out, XB, SS + (size_t)12 * NTOK * 32, P.final_g, lane, wave, G); }
    END_STEP;
#undef RUN_STEP
#undef END_STEP
}

#ifndef MK_MULTI
#define MK_MULTI 0
#endif
extern "C" void kernel_launch(void* const* d_in, const int* in_sizes, int n_in, void* d_out, int out_size, void* d_ws, size_t ws_size, hipStream_t stream) {
    static int grid = 0;
    if (grid == 0) {
        if (n_in != 12 || out_size != NTOK * DM || ws_size < WS_END) { fprintf(stderr, "kernel_launch: unexpected problem (n_in %d, out %d, ws %zu)\n", n_in, out_size, ws_size); grid = -1; return; }
        int dev = 0, cus = 0, per_cu = 0;
        if (hipGetDevice(&dev) != hipSuccess || hipDeviceGetAttribute(&cus, hipDeviceAttributeMultiprocessorCount, dev) != hipSuccess) { grid = -1; return; }
        if (hipFuncSetAttribute((const void*)fwd, hipFuncAttributeMaxDynamicSharedMemorySize, LDS_BYTES) != hipSuccess) { fprintf(stderr, "kernel_launch: hipFuncSetAttribute failed\n"); grid = -1; return; }
        if (hipOccupancyMaxActiveBlocksPerMultiprocessor(&per_cu, (const void*)fwd, 512, LDS_BYTES) != hipSuccess || per_cu < 1) { fprintf(stderr, "kernel_launch: occupancy query says %d\n", per_cu); }
        (void)hipGetLastError();
        grid = cus;
    }
    if (grid < 0) return;
    (void)hipMemsetAsync((char*)d_ws + WS_CTL, 0, CTL_ZERO_BYTES, stream);
    Args a{};
    a.p.x_prompt = (const float*)d_in[0]; a.p.x_sample = (const float*)d_in[1]; a.p.norm_g = (const float*)d_in[2]; a.p.ffn_gate = (const float*)d_in[3];
    a.p.ffn_up = (const float*)d_in[4]; a.p.ffn_down = (const float*)d_in[5]; a.p.w_in = (const float*)d_in[6]; a.p.w_pool = (const float*)d_in[7];
    a.p.pool_scale = (const float*)d_in[8]; a.p.w_out = (const float*)d_in[9]; a.p.rel_bias = (const float*)d_in[10]; a.p.final_g = (const float*)d_in[11];
    a.p.out = (float*)d_out; a.p.ws = (unsigned char*)d_ws;
#if MK_MULTI
    for (int s = 0; s < NSTEPS; ++s) { a.lo = s; a.hi = s + 1; hipLaunchKernelGGL(fwd, dim3(grid), dim3(512), LDS_BYTES, stream, a); }
#else
    a.lo = 0; a.hi = 1 << 30;
    hipLaunchKernelGGL(fwd, dim3(grid), dim3(512), LDS_BYTES, stream, a);
#endif
}
```
